# Optimizing an MI355X kernel written in HIP

```python
import math
import jax, jax.numpy as jnp
from jax import lax
import numpy as np

D_MODEL = 1024
BATCH = 8
SEQ = 2048
DEPTH = 2

HEAD_DIM = 64
SSD_WIDTH = D_MODEL // 2
SSD_HEADS = SSD_WIDTH // HEAD_DIM
SSD_GROUPS = 2
SSD_STATE = 128
SSD_CONV = 4
SSD_CHUNK = 128
SSD_CONV_DIM = SSD_WIDTH + 2 * SSD_GROUPS * SSD_STATE
SB_WIDTH = D_MODEL // 4
SB_HEADS = SB_WIDTH // HEAD_DIM
SB_BLOCK = 128
NSA_WIDTH = D_MODEL // 4
NSA_HEADS = NSA_WIDTH // HEAD_DIM
CMP_LEN = 32
CMP_STRIDE = 16
SEL_BLOCK = 64
SEL_TOPK = 16
WINDOW = 512
NSA_QBLOCK = 128
FORCE_SCORE = 1e9
MIX_WIDTH = SSD_WIDTH + SB_WIDTH + NSA_WIDTH
ROT_DIM = HEAD_DIM // 4
ROPE_THETA = 500000.0
PEER_HEADS = 8
N_KEYS = 128
N_EXPERTS = N_KEYS * N_KEYS
PEER_TOPK = 16
PEER_QDIM = 256
PEER_TOKEN_BLOCK = 128
NORM_EPS = 1e-6
IN_SIZES = (SSD_WIDTH, SSD_CONV_DIM, SSD_HEADS, 3 * SB_WIDTH, NSA_WIDTH, 6 * HEAD_DIM, 3 * NSA_HEADS)
IN_DIM = sum(IN_SIZES)
IN_SPLITS = tuple(sum(IN_SIZES[:i + 1]) for i in range(len(IN_SIZES) - 1))

kernel_name = "hybrid_ssd_stickbreak_nsa_peer"


def rms_norm(x, w):
    xf = x.astype(jnp.float32)
    y = xf * lax.rsqrt(jnp.mean(xf * xf, axis=-1, keepdims=True) + NORM_EPS)
    return (y * w.astype(jnp.float32)).astype(x.dtype)


def rope_tables(seq_len):
    pos = jnp.arange(seq_len, dtype=jnp.float32)
    inv_freq = ROPE_THETA ** (-jnp.arange(0, ROT_DIM, 2, dtype=jnp.float32) / ROT_DIM)
    ang = pos[:, None] * inv_freq[None, :]
    return jnp.cos(ang), jnp.sin(ang)


def partial_rope(x, cos, sin):
    half = ROT_DIM // 2
    x1, x2, rest = x[..., :half], x[..., half:ROT_DIM], x[..., ROT_DIM:]
    c, s = cos.astype(x.dtype), sin.astype(x.dtype)
    return jnp.concatenate([x1 * c - x2 * s, x2 * c + x1 * s, rest], axis=-1)


def causal_depthwise_conv(x, w):
    return lax.conv_general_dilated(
        x, w[:, None, :], window_strides=(1,), padding=[(w.shape[0] - 1, 0)],
        dimension_numbers=('NWC', 'WIO', 'NWC'), feature_group_count=x.shape[-1])


def segsum(x):
    T = x.shape[-1]
    xr = jnp.broadcast_to(x[..., :, None], x.shape + (T,))
    strict = jnp.tril(jnp.ones((T, T), dtype=bool), -1)
    ss = jnp.cumsum(jnp.where(strict, xr, 0.0), axis=-2)
    return jnp.where(jnp.tril(jnp.ones((T, T), dtype=bool)), ss, -jnp.inf)


def ssd_mixer(z, xbc, dt_raw, conv_w, conv_b, dt_bias, a_log, d_skip, norm_w):
    Bsz, S, _ = z.shape
    G, R, P, N, L = SSD_GROUPS, SSD_HEADS // SSD_GROUPS, HEAD_DIM, SSD_STATE, SSD_CHUNK
    nc = S // L
    xbc = jax.nn.silu(causal_depthwise_conv(xbc, conv_w) + conv_b)
    xs, b_in, c_in = jnp.split(xbc, [SSD_WIDTH, SSD_WIDTH + G * N], axis=-1)
    dt = jax.nn.softplus((dt_raw + dt_bias).astype(jnp.float32))
    a = -jnp.exp(a_log.astype(jnp.float32))
    xh = xs.reshape(Bsz, S, SSD_HEADS, P)
    X = (xh * dt[..., None]).reshape(Bsz, nc, L, G, R, P)
    Bm = b_in.reshape(Bsz, nc, L, G, N)
    Cm = c_in.reshape(Bsz, nc, L, G, N)
    A = (dt * a).reshape(Bsz, nc, L, G, R).transpose(0, 3, 4, 1, 2)
    A_cs = jnp.cumsum(A, axis=-1)
    Lmat = jnp.exp(segsum(A))
    CB = jnp.einsum('bclgn,bcsgn->bgcls', Cm, Bm)
    y_diag = jnp.einsum('bgrcls,bcsgrp->bclgrp', Lmat * CB[:, :, None], X)
    decay_states = jnp.exp(A_cs[..., -1:] - A_cs).transpose(0, 3, 4, 1, 2)
    states = jnp.einsum('bclgn,bclgrp->bcgrpn', Bm, X * decay_states[..., None])
    states = jnp.concatenate([jnp.zeros_like(states[:, :1]), states], axis=1)
    A_last = jnp.pad(A_cs[..., -1], ((0, 0), (0, 0), (0, 0), (1, 0)))
    decay_chunk = jnp.exp(segsum(A_last))
    states = jnp.einsum('bgrzc,bcgrpn->bzgrpn', decay_chunk, states)[:, :-1]
    y_off = jnp.einsum('bclgn,bcgrpn->bclgrp', Cm, states) * jnp.exp(A_cs).transpose(0, 3, 4, 1, 2)[..., None]
    y = (y_diag + y_off).reshape(Bsz, S, SSD_HEADS, P) + xh * d_skip[:, None]
    y = y.reshape(Bsz, S, SSD_WIDTH)
    return rms_norm(y * jax.nn.silu(z), norm_w)


def stick_breaking_attention(qkv):
    Bsz, S, _ = qkv.shape
    H, d = SB_HEADS, HEAD_DIM
    q, k, v = [u.reshape(Bsz, S, H, d).transpose(0, 2, 1, 3) for u in jnp.split(qkv, 3, axis=-1)]
    nqb = S // SB_BLOCK
    q_blocks = q.reshape(Bsz, H, nqb, SB_BLOCK, d).transpose(2, 0, 1, 3, 4)
    starts = jnp.arange(nqb) * SB_BLOCK
    kpos = jnp.arange(S)
    scale = d ** -0.5

    def block(args):
        qi, t0 = args
        tq = t0 + jnp.arange(SB_BLOCK)
        mask = kpos[None, :] < tq[:, None]
        z = (jnp.einsum('bhqd,bhkd->bhqk', qi, k) * scale).astype(jnp.float32)
        log_beta = jnp.where(mask, jax.nn.log_sigmoid(z), -jnp.inf)
        log_stay = jnp.where(mask, jax.nn.log_sigmoid(-z), 0.0)
        log_after = lax.cumsum(log_stay, axis=log_stay.ndim - 1, reverse=True) - log_stay
        w = jnp.exp(log_beta + log_after)
        return jnp.einsum('bhqk,bhkd->bhqd', w.astype(v.dtype), v)

    o = lax.map(block, (q_blocks, starts))
    return o.transpose(1, 0, 3, 2, 4).reshape(Bsz, S, H * d)


def nsa_attention(q, kv, gate_logits, q_norm_w, k_norm_w, cmp_pos, cmp_w, cos, sin):
    Bsz, S, _ = q.shape
    H, d = NSA_HEADS, HEAD_DIM
    scale = d ** -0.5
    t = jnp.arange(S)
    kc, vc, ks, vs, kw, vw = jnp.split(kv, 6, axis=-1)
    q = partial_rope(rms_norm(q.reshape(Bsz, S, H, d), q_norm_w).transpose(0, 2, 1, 3), cos, sin)

    n_cmp = (S - CMP_LEN) // CMP_STRIDE + 1
    cmp_start = np.arange(n_cmp) * CMP_STRIDE
    tok = cmp_start[:, None] + np.arange(CMP_LEN)[None, :]
    kc_blk = (partial_rope(kc, cos, sin)[:, tok] + cmp_pos[0]).reshape(Bsz, n_cmp, CMP_LEN * d)
    k_cmp = rms_norm(kc_blk @ cmp_w[0], k_norm_w[0])
    v_cmp = (vc[:, tok] + cmp_pos[1]).reshape(Bsz, n_cmp, CMP_LEN * d) @ cmp_w[1]
    cmp_visible = jnp.asarray(cmp_start + CMP_LEN - 1)[None, :] <= t[:, None]
    s_cmp = (jnp.einsum('bhsd,bcd->bhsc', q, k_cmp) * scale).astype(jnp.float32)
    p_cmp = jax.nn.softmax(jnp.where(cmp_visible, s_cmp, -1e30), axis=-1) * cmp_visible
    o_cmp = jnp.einsum('bhsc,bcd->bhsd', p_cmp.astype(v_cmp.dtype), v_cmp)

    n_sel = S // SEL_BLOCK
    sel_start = np.arange(n_sel) * SEL_BLOCK
    overlap = ((cmp_start[:, None] < sel_start[None, :] + SEL_BLOCK)
               & (cmp_start[:, None] + CMP_LEN > sel_start[None, :])).astype(np.float32)
    imp = jnp.einsum('bhsc,cj->bsj', p_cmp, jnp.asarray(overlap))
    j = jnp.arange(n_sel)[None, :]
    blk_t = (t // SEL_BLOCK)[:, None]
    forced = (j == 0) | (j == blk_t) | (j == blk_t - 1)
    causal = j * SEL_BLOCK <= t[:, None]
    imp = jnp.where(causal, jnp.where(forced, FORCE_SCORE, imp), -jnp.inf)
    n_top = min(SEL_TOPK, n_sel)
    _, sel_idx = lax.top_k(imp, n_top)

    ks = partial_rope(rms_norm(ks, k_norm_w[1]), cos, sin)
    kw = partial_rope(rms_norm(kw, k_norm_w[2]), cos, sin)
    ks_blk = ks.reshape(Bsz, n_sel, SEL_BLOCK, d)
    vs_blk = vs.reshape(Bsz, n_sel, SEL_BLOCK, d)
    kw_pad = jnp.pad(kw, ((0, 0), (WINDOW, 0), (0, 0)))
    vw_pad = jnp.pad(vw, ((0, 0), (WINDOW, 0), (0, 0)))
    nqb = S // NSA_QBLOCK
    q_blocks = q.reshape(Bsz, H, nqb, NSA_QBLOCK, d).transpose(2, 0, 1, 3, 4)
    idx_blocks = sel_idx.reshape(Bsz, nqb, NSA_QBLOCK, n_top).transpose(1, 0, 2, 3)
    starts = jnp.arange(nqb) * NSA_QBLOCK
    take_blocks = jax.vmap(lambda blocks, idx: blocks[idx])
    n_win = WINDOW + NSA_QBLOCK

    def block(args):
        qi, idx, t0 = args
        tq = t0 + jnp.arange(NSA_QBLOCK)
        k_g = take_blocks(ks_blk, idx).reshape(Bsz, NSA_QBLOCK, n_top * SEL_BLOCK, d)
        v_g = take_blocks(vs_blk, idx).reshape(Bsz, NSA_QBLOCK, n_top * SEL_BLOCK, d)
        kpos = (idx[..., None] * SEL_BLOCK + jnp.arange(SEL_BLOCK)).reshape(Bsz, NSA_QBLOCK, n_top * SEL_BLOCK)
        m_sel = (kpos <= tq[None, :, None])[:, None]
        s_sel = (jnp.einsum('bhqd,bqkd->bhqk', qi, k_g) * scale).astype(jnp.float32)
        p_sel = jax.nn.softmax(jnp.where(m_sel, s_sel, -1e30), axis=-1)
        o_sel = jnp.einsum('bhqk,bqkd->bhqd', p_sel.astype(v_g.dtype), v_g)
        k_w = lax.dynamic_slice_in_dim(kw_pad, t0, n_win, axis=1)
        v_w = lax.dynamic_slice_in_dim(vw_pad, t0, n_win, axis=1)
        kpos_w = t0 - WINDOW + jnp.arange(n_win)
        rel = tq[:, None] - kpos_w[None, :]
        m_win = (rel >= 0) & (rel < WINDOW) & (kpos_w[None, :] >= 0)
        s_win = (jnp.einsum('bhqd,bkd->bhqk', qi, k_w) * scale).astype(jnp.float32)
        p_win = jax.nn.softmax(jnp.where(m_win, s_win, -1e30), axis=-1)
        o_win = jnp.einsum('bhqk,bkd->bhqd', p_win.astype(v_w.dtype), v_w)
        return o_sel, o_win

    o_sel, o_win = lax.map(block, (q_blocks, idx_blocks, starts))
    unblock = lambda o: o.transpose(1, 2, 0, 3, 4).reshape(Bsz, H, S, d)
    g = jax.nn.sigmoid(gate_logits.reshape(Bsz, S, H, 3).astype(jnp.float32)).transpose(0, 2, 1, 3)
    o = g[..., 0:1] * o_cmp + g[..., 1:2] * unblock(o_sel) + g[..., 2:3] * unblock(o_win)
    return o.transpose(0, 2, 1, 3).reshape(Bsz, S, NSA_WIDTH)


def peer_ffn(h, w_q, sub_keys, u_tab, v_tab):
    Bsz, S, D = h.shape
    T = Bsz * S
    Tb = PEER_TOKEN_BLOCK
    half = PEER_QDIM // 2

    def block(xb):
        q = (xb @ w_q).reshape(Tb, PEER_HEADS, 2, half)
        s = jnp.einsum('thpd,pkd->thpk', q, sub_keys).astype(jnp.float32)
        sv, si = lax.top_k(s, PEER_TOPK)
        cand = sv[:, :, 0, :, None] + sv[:, :, 1, None, :]
        cv, ci = lax.top_k(cand.reshape(Tb, PEER_HEADS, PEER_TOPK * PEER_TOPK), PEER_TOPK)
        i1 = jnp.take_along_axis(si[:, :, 0, :], ci // PEER_TOPK, axis=-1)
        i2 = jnp.take_along_axis(si[:, :, 1, :], ci % PEER_TOPK, axis=-1)
        eidx = i1 * N_KEYS + i2
        g = jax.nn.softmax(cv, axis=-1)
        u = u_tab[eidx]
        v = v_tab[eidx]
        a = jax.nn.gelu(jnp.einsum('thkd,td->thk', u, xb).astype(jnp.float32), approximate=False)
        return jnp.einsum('thk,thkd->td', (g * a).astype(v.dtype), v)

    out = lax.map(block, h.reshape(T // Tb, Tb, D))
    return out.reshape(Bsz, S, D)


def setup_inputs(seed: int = 0) -> dict:
    key = jax.random.key(seed)
    ks = jax.random.split(key, 24)
    L, D = DEPTH, D_MODEL
    nrm = lambda k, shape, scale: jax.random.normal(k, shape, jnp.float32) * scale
    dt0 = jnp.exp(jax.random.uniform(ks[5], (L, SSD_HEADS), jnp.float32, math.log(1e-3), math.log(1e-1)))
    return {
        "x": nrm(ks[0], (BATCH, SEQ, D), 1.0),
        "norm1_w": 1.0 + nrm(ks[1], (L, D), 0.02),
        "w_in": nrm(ks[2], (L, D, IN_DIM), D ** -0.5),
        "conv_w": nrm(ks[3], (L, SSD_CONV, SSD_CONV_DIM), SSD_CONV ** -0.5),
        "conv_b": nrm(ks[4], (L, SSD_CONV_DIM), 0.02),
        "dt_bias": dt0 + jnp.log(-jnp.expm1(-dt0)),
        "a_log": jnp.log(jax.random.uniform(ks[6], (L, SSD_HEADS), jnp.float32, 1.0, 16.0)),
        "d_skip": 1.0 + nrm(ks[7], (L, SSD_HEADS), 0.02),
        "ssd_norm_w": 1.0 + nrm(ks[8], (L, SSD_WIDTH), 0.02),
        "sb_out_w": 1.0 + nrm(ks[9], (L, SB_WIDTH), 0.02),
        "nsa_q_norm_w": 1.0 + nrm(ks[10], (L, HEAD_DIM), 0.02),
        "nsa_k_norm_w": 1.0 + nrm(ks[11], (L, 3, HEAD_DIM), 0.02),
        "nsa_cmp_pos": nrm(ks[12], (L, 2, CMP_LEN, HEAD_DIM), 0.1),
        "nsa_cmp_w": nrm(ks[13], (L, 2, CMP_LEN * HEAD_DIM, HEAD_DIM), (CMP_LEN * HEAD_DIM) ** -0.5),
        "nsa_out_w": 1.0 + nrm(ks[14], (L, NSA_WIDTH), 0.02),
        "w_out": nrm(ks[15], (L, MIX_WIDTH, D), MIX_WIDTH ** -0.5),
        "norm2_w": 1.0 + nrm(ks[16], (L, D), 0.02),
        "peer_w_q": nrm(ks[17], (L, D, PEER_HEADS * PEER_QDIM), D ** -0.5),
        "peer_sub_keys": nrm(ks[18], (L, 2, N_KEYS, PEER_QDIM // 2), (PEER_QDIM // 2) ** -0.5),
        "peer_u": nrm(ks[19], (L, N_EXPERTS, D), D ** -0.5),
        "peer_v": nrm(ks[20], (L, N_EXPERTS, D), (PEER_HEADS * PEER_TOPK) ** -0.5),
    }


def reference(x, norm1_w, w_in, conv_w, conv_b, dt_bias, a_log, d_skip, ssd_norm_w, sb_out_w,
              nsa_q_norm_w, nsa_k_norm_w, nsa_cmp_pos, nsa_cmp_w, nsa_out_w, w_out, norm2_w,
              peer_w_q, peer_sub_keys, peer_u, peer_v):
    cos, sin = rope_tables(x.shape[1])
    for l in range(DEPTH):
        h = rms_norm(x, norm1_w[l])
        proj = h @ w_in[l]
        z, xbc, dt_raw, sb_qkv, nsa_q, nsa_kv, nsa_gate = jnp.split(proj, IN_SPLITS, axis=-1)
        y_ssd = ssd_mixer(z, xbc, dt_raw, conv_w[l], conv_b[l], dt_bias[l], a_log[l], d_skip[l], ssd_norm_w[l])
        y_sb = rms_norm(stick_breaking_attention(sb_qkv), sb_out_w[l])
        y_nsa = rms_norm(nsa_attention(nsa_q, nsa_kv, nsa_gate, nsa_q_norm_w[l], nsa_k_norm_w[l],
                                       nsa_cmp_pos[l], nsa_cmp_w[l], cos, sin), nsa_out_w[l])
        mixed = jnp.concatenate([y_ssd, y_sb, y_nsa], axis=-1).astype(x.dtype) @ w_out[l]
        x = x + mixed
        x = x + peer_ffn(rms_norm(x, norm2_w[l]), peer_w_q[l], peer_sub_keys[l], peer_u[l], peer_v[l]).astype(x.dtype)
    return x
```

```cpp
#include <hip/hip_runtime.h>
#include <hip/hip_cooperative_groups.h>
#include <cstdio>
#include <cstdint>
namespace cg = cooperative_groups;

typedef unsigned short bf16;
constexpr int D = 1024, BATCH = 8, SEQ = 2048, T = BATCH * SEQ, NL = 2;
constexpr int IN_DIM = 2964, INP = 3072;
constexpr int C_Z = 0, C_XBC = 512, C_DT = 1536, C_SB = 1544, C_NQ = 2312, C_NKV = 2568, C_GATE = 2952;
constexpr int NTHREADS = 512;
constexpr int LDS_BYTES = 147456;
constexpr float EPS = 1e-6f;
#ifndef ONLY
#define ONLY 0
#endif
#define SEL(n) (ONLY == 0 || ONLY == (n))
#ifndef DUP
#define DUP 0
#endif
#define DUPHIT(n) (DUP == (n) || (DUP == 56 && ((n) == 5 || (n) == 6)) || (DUP == 34 && ((n) == 3 || (n) == 4)) || (DUP == 1012 && ((n) == 10 || (n) == 12)))
#define REP(n) for (int _rep = 0; _rep < (DUPHIT(n) ? 2 : 1); ++_rep)

constexpr size_t MiB = 1u << 20;
constexpr size_t O_CTL = 0, O_WIN = 1 * MiB, O_WOUT = 13 * MiB, O_WQ = 17 * MiB, O_UT = 25 * MiB, O_VT = 89 * MiB, O_H1 = 153 * MiB,
                 O_PROJ = 185 * MiB, O_XBC = 281 * MiB, O_MIX = 313 * MiB, O_X1 = 345 * MiB, O_QN = 409 * MiB, O_KS = 417 * MiB, O_KW = 419 * MiB,
                 O_KC = 421 * MiB, O_KCMP = 423 * MiB, O_VCMP = 423 * MiB + 512 * 1024, O_DT = 424 * MiB, O_SEL = 425 * MiB, O_TV = 426 * MiB,
                 O_TI = 442 * MiB, O_EI = 458 * MiB, O_EG = 466 * MiB, O_ROPE = 474 * MiB, O_WCT = 475 * MiB, O_OC = 476 * MiB, WS_END = 492 * MiB;
constexpr size_t O_PBIAS = O_ROPE + 512 * 1024, O_USC = O_ROPE + 576 * 1024, O_VSC = O_ROPE + 704 * 1024, O_KYB = O_ROPE + 832 * 1024;
constexpr size_t O_SIN = O_OC;
constexpr size_t O_SLOC = O_TV, O_ATOT = O_EI;
constexpr size_t O_Q = O_PROJ, O_MIXN = O_XBC, O_H2 = O_MIX, O_PC = O_X1, O_NSAO = O_X1 + 32 * MiB;

struct Params {
    const float *x, *norm1_w, *w_in, *conv_w, *conv_b, *dt_bias, *a_log, *d_skip, *ssd_norm_w, *sb_out_w, *nsa_q_norm_w, *nsa_k_norm_w,
        *nsa_cmp_pos, *nsa_cmp_w, *nsa_out_w, *w_out, *norm2_w, *peer_w_q, *peer_sub_keys, *peer_u, *peer_v;
    float* out;
    unsigned char* ws;
};

__device__ __forceinline__ float bf2f(bf16 v) { return __uint_as_float(((unsigned)v) << 16); }
typedef __bf16 bf16pair_t __attribute__((ext_vector_type(2)));
typedef float f32pair_t __attribute__((ext_vector_type(2)));
__device__ __forceinline__ unsigned pk2(float lo, float hi) { const f32pair_t v = {lo, hi}; return __builtin_bit_cast(unsigned, __builtin_convertvector(v, bf16pair_t)); }
__device__ __forceinline__ bf16 f2bf(float f) { return (bf16)(pk2(f, 0.f) & 0xffffu); }
__device__ __forceinline__ float wave_sum(float v) {
#pragma unroll
    for (int o = 1; o < 64; o <<= 1) v += __shfl_xor(v, o);
    return v;
}
__device__ __forceinline__ void unpack8(uint4 u, float* f) {
    f[0] = __uint_as_float(u.x << 16); f[1] = __uint_as_float(u.x & 0xffff0000u);
    f[2] = __uint_as_float(u.y << 16); f[3] = __uint_as_float(u.y & 0xffff0000u);
    f[4] = __uint_as_float(u.z << 16); f[5] = __uint_as_float(u.z & 0xffff0000u);
    f[6] = __uint_as_float(u.w << 16); f[7] = __uint_as_float(u.w & 0xffff0000u);
}
__device__ __forceinline__ float fexp(float v) { return __builtin_amdgcn_exp2f(v * 1.44269504088896341f); }
__device__ __forceinline__ float frcp(float v) { return __builtin_amdgcn_rcpf(v); }
__device__ __forceinline__ float siluf(float v) { return v * frcp(1.f + fexp(-v)); }
__device__ __forceinline__ float sigmoidf_(float v) { return frcp(1.f + fexp(-v)); }
__device__ __forceinline__ float softplusf(float v) { return fmaxf(v, 0.f) + log1pf(expf(-fabsf(v))); }
__device__ __forceinline__ float softplus_fast(float v) { return fmaxf(v, 0.f) + 0.693147180559945f * __builtin_amdgcn_logf(1.f + fexp(-fabsf(v))); }

namespace pg8 {
#define PG8_LAS __attribute__((address_space(3)))
typedef unsigned short bf16_t;
typedef short bf16x8 __attribute__((ext_vector_type(8)));
typedef float f32x4 __attribute__((ext_vector_type(4)));
typedef unsigned u32x4 __attribute__((ext_vector_type(4)));
constexpr int BM = 256, BK = 64, HALF = 128, HTB = HALF * BK * 2  , STAGE_BYTES = 8 * HTB, NXCD = 8, WGM = 8;

__host__ __device__ __forceinline__ int lds_byte(int r, int c) { const int st = (r >> 4) * 2 + (c >> 5), rr = r & 15, cc = c & 31, ob = rr * 64 + cc * 2; return st * 1024 + (ob ^ (((ob >> 9) & 1) << 5)); }
__host__ __device__ __forceinline__ void stage_rc(int b, int& R, int& C) { const int st = b / 1024, sb = b % 1024, swz = sb ^ (((sb >> 9) & 1) << 5); R = (st >> 1) * 16 + swz / 64; C = (st & 1) * 32 + (swz % 64) / 2; }
__host__ __device__ __forceinline__ int perm32(int rho) { const int n = rho >> 4, i = rho & 15; return 8 * (i >> 2) + 4 * n + (i & 3); }

struct Unit { int pm, pn; };
struct Gemm { const bf16_t* A; const bf16_t* Bt; int M, N, K; };

struct StaticOrder {
    int nM, nN, nwg, G, c;
    __host__ __device__ void init(int M, int N, int G_, int c_) { nM = M / BM; nN = N / BM; nwg = nM * nN; G = G_; c = c_; }
    __host__ __device__ bool next(int i, Unit& u) const {
        const long L = (long)i * G + c; if (L >= nwg) return false;
        int wgid = (int)L; { const int q = nwg / NXCD, r = nwg % NXCD, xcd = wgid % NXCD, off = wgid / NXCD; wgid = (xcd < r ? xcd * (q + 1) : r * (q + 1) + (xcd - r) * q) + off; }
        const int nig = WGM * nN, gid = wgid / nig, fm = gid * WGM, gsz = (nM - fm) < WGM ? (nM - fm) : WGM;
        u.pm = fm + ((wgid % nig) % gsz); u.pn = (wgid % nig) / gsz; return true;
    }
    __device__ __forceinline__ void a_ready(const Unit&) const {}
    __device__ __forceinline__ void done(const Unit&) const {}
};

__device__ __forceinline__ unsigned cvt_pk_bf16(float lo, float hi) { unsigned r; asm volatile("v_cvt_pk_bf16_f32 %0, %1, %2" : "=v"(r) : "v"(lo), "v"(hi)); return r; }
typedef float f32x2 __attribute__((ext_vector_type(2)));
__device__ __forceinline__ f32x2 gelu_pk(f32x2 v) {
    const f32x2 av = __builtin_elementwise_abs(v), d = av * 0.2316418882f + 1.0f;
    f32x2 t; t.x = __builtin_amdgcn_rcpf(d.x); t.y = __builtin_amdgcn_rcpf(d.y);
    f32x2 q = t * 0.5307027145f + (-0.7265760135f); q = q * t + 0.7107068705f; q = q * t + (-0.142248368f); q = q * t + 0.127414796f; q = q * t;
    const f32x2 s = (v * v) * (-0.72134752044f);
    f32x2 e; e.x = __builtin_amdgcn_exp2f(s.x); e.y = __builtin_amdgcn_exp2f(s.y);
    const f32x2 m = v * (q * e), r = v - m;
    f32x2 o; o.x = v.x < 0.f ? m.x : r.x; o.y = v.y < 0.f ? m.y : r.y; return o;
}

template <int ACT  > struct EpiBf16 {
    static constexpr bool PERM = true, AFTER_DRAIN = false; static_assert(ACT == 0 || ACT == 1, "EpiBf16: ACT is 0 (none) or 1 (gelu_pk)");
    bf16_t* O; int ldc; const float* bias; int split_cols; size_t split_stride; float scale0;
    __device__ __forceinline__ void operator()(const f32x4 (&acc)[2][2][4][2], const Unit& u, int wr, int wc, int fr, int fq) const {
        const int row0 = u.pm * BM + wr * 64 + fr; int colt = u.pn * BM; bf16_t* base = O;
        float sc = 1.f; if (split_cols) { const int t = colt / split_cols; base += (size_t)t * split_stride; colt -= t * split_cols; if (t == 0) sc = scale0; }
        const int col0 = colt + wc * 32 + 8 * fq, bcol0 = u.pn * BM + wc * 32 + 8 * fq;
        f32x4 bv[2][2];
#pragma unroll
        for (int bj = 0; bj < 2; ++bj)
#pragma unroll
            for (int n = 0; n < 2; ++n) bv[bj][n] = bias ? *(const f32x4*)(bias + bcol0 + bj * HALF + 4 * n) : (f32x4){0.f, 0.f, 0.f, 0.f};
#pragma unroll
        for (int ai = 0; ai < 2; ++ai)
#pragma unroll
            for (int m = 0; m < 4; ++m) { bf16_t* rowp = base + (size_t)(row0 + ai * HALF + m * 16) * ldc + col0;
#pragma unroll
                for (int bj = 0; bj < 2; ++bj) { f32x4 v0 = acc[ai][bj][m][0] + bv[bj][0], v1 = acc[ai][bj][m][1] + bv[bj][1];
                    if (ACT == 1) { f32x2 a = gelu_pk((f32x2){v0[0], v0[1]}), b = gelu_pk((f32x2){v0[2], v0[3]}), c = gelu_pk((f32x2){v1[0], v1[1]}), d = gelu_pk((f32x2){v1[2], v1[3]});
                        v0 = (f32x4){a.x, a.y, b.x, b.y}; v1 = (f32x4){c.x, c.y, d.x, d.y}; }
                    v0 = v0 * sc; v1 = v1 * sc; u32x4 w; w.x = cvt_pk_bf16(v0[0], v0[1]); w.y = cvt_pk_bf16(v0[2], v0[3]); w.z = cvt_pk_bf16(v1[0], v1[1]); w.w = cvt_pk_bf16(v1[2], v1[3]);
                    *(u32x4*)(rowp + bj * HALF) = w; } }
    }
};

struct EpiResF32 {
    static constexpr bool PERM = false, AFTER_DRAIN = false;
    float* C; const float* R; int ldc;
    __device__ __forceinline__ void operator()(const f32x4 (&acc)[2][2][4][2], const Unit& u, int wr, int wc, int fr, int fq) const {
        const int row0 = u.pm * BM + wr * 64 + fr, col0 = u.pn * BM + wc * 32 + 4 * fq;
#pragma unroll
        for (int ai = 0; ai < 2; ++ai)
            {
                f32x4 rv[4][2][2];
#pragma unroll
                for (int m = 0; m < 4; ++m) { const size_t off = (size_t)(row0 + ai * HALF + m * 16) * ldc + col0;
#pragma unroll
                    for (int bj = 0; bj < 2; ++bj)
#pragma unroll
                        for (int n = 0; n < 2; ++n) rv[m][bj][n] = *(const f32x4*)(R + off + bj * HALF + n * 16); }
#pragma unroll
                for (int m = 0; m < 4; ++m) { const size_t off = (size_t)(row0 + ai * HALF + m * 16) * ldc + col0;
#pragma unroll
                    for (int bj = 0; bj < 2; ++bj)
#pragma unroll
                        for (int n = 0; n < 2; ++n) *(f32x4*)(C + off + bj * HALF + n * 16) = acc[ai][bj][m][n] + rv[m][bj][n]; } }
    }
};

template <class Epi, class Sched, bool ALIGN_EPI = false, bool SP2 = false>
__device__ __forceinline__ void gemm_phase(PG8_LAS unsigned char* lds, const Gemm g, const Sched& S, const Epi& E, const int tid_in) {
    int tid_l = tid_in; asm volatile("" : "+v"(tid_l));
    const int tid = tid_l, wid = __builtin_amdgcn_readfirstlane(tid >> 6), lane = tid & 63, wr = wid >> 2, wc = wid & 3, fr = lane & 15, fq = lane >> 4;
    const int K = g.K, nt = K / BK;
    unsigned voffA[2], voffB[2];
#pragma unroll
    for (int i = 0; i < 2; ++i) { int R, C; stage_rc(tid * 16 + i * 8192, R, C); const int Rb = Epi::PERM ? ((R & ~31) + perm32(R & 31)) : R;
        voffA[i] = (unsigned)(R * K + C) * 2u; voffB[i] = (unsigned)(Rb * K + C) * 2u; }
    const size_t kstep = (size_t)(BK * 2);
    const size_t hstep = (size_t)HALF * K * 2;
    const size_t tstep = 2 * hstep;
    const unsigned ldsw = (unsigned)wid * 1024u;
    const int aoff = lds_byte(wr * 64 + fr, fq * 8), boff = lds_byte(wc * 32 + fr, fq * 8);
#define PG8_SA(b, h) (((b) * 2 + (h)) * HTB)
#define PG8_SB(b, h) ((4 + (b) * 2 + (h)) * HTB)
#define PG8_STAGE(bufoff, gbase, voff) do { _Pragma("unroll") for (int _i = 0; _i < 2; ++_i) \
        __builtin_amdgcn_global_load_lds((const unsigned*)((const char*)(gbase) + (voff)[_i]), (PG8_LAS unsigned*)(lds + (bufoff) + ldsw + _i * 8192), 16, 0, 0); } while (0)
#define PG8_LDA(dst, b, h) do { _Pragma("unroll") for (int m = 0; m < 4; ++m) _Pragma("unroll") for (int k = 0; k < 2; ++k) dst[m][k] = *(const PG8_LAS bf16x8*)(lds + PG8_SA(b, h) + aoff + m * 2048 + k * 1024); } while (0)
#define PG8_LDB(dst, b, h) do { _Pragma("unroll") for (int n = 0; n < 2; ++n) _Pragma("unroll") for (int k = 0; k < 2; ++k) dst[n][k] = *(const PG8_LAS bf16x8*)(lds + PG8_SB(b, h) + boff + n * 2048 + k * 1024); } while (0)
#define PG8_MMA(ai, bj, At, Bt) do { __builtin_amdgcn_s_setprio(1); _Pragma("unroll") for (int m = 0; m < 4; ++m) _Pragma("unroll") for (int n = 0; n < 2; ++n) _Pragma("unroll") for (int k = 0; k < 2; ++k) \
        acc[ai][bj][m][n] = __builtin_amdgcn_mfma_f32_16x16x32_bf16(Bt[n][k], At[m][k], acc[ai][bj][m][n], 0, 0, 0); __builtin_amdgcn_s_setprio(0); } while (0)
#define PG8_WAIT_V(n) asm volatile("s_waitcnt vmcnt(" #n ")" ::: "memory")
#define PG8_WAIT_L(n) asm volatile("s_waitcnt lgkmcnt(" #n ")" ::: "memory")
#define PG8_BAR __builtin_amdgcn_s_barrier()
#define PG8_SCHED __builtin_amdgcn_sched_barrier(0)
    Unit cur, nxt; int ui = 0;
    if (!S.next(0, cur)) return;
    f32x4 acc[2][2][4][2];
#pragma unroll
    for (int a = 0; a < 2; ++a)
#pragma unroll
        for (int b = 0; b < 2; ++b)
#pragma unroll
            for (int m = 0; m < 4; ++m)
#pragma unroll
                for (int n = 0; n < 2; ++n) acc[a][b][m][n] = (f32x4){0.f, 0.f, 0.f, 0.f};
    bf16x8 At[4][2], B0[2][2], B1[2][2];
    const char* cA = (const char*)g.A + (size_t)cur.pm * tstep; const char* cB = (const char*)g.Bt + (size_t)cur.pn * tstep;
    S.a_ready(cur);
    if constexpr (SP2) {
        PG8_STAGE(PG8_SB(0, 0), cB, voffB); PG8_STAGE(PG8_SB(0, 1), cB + hstep, voffB); PG8_STAGE(PG8_SA(0, 0), cA, voffA); PG8_STAGE(PG8_SA(0, 1), cA + hstep, voffA);
        if (wr == 1) PG8_BAR;
        PG8_WAIT_V(2); PG8_BAR;
        PG8_STAGE(PG8_SB(1, 0), cB + kstep, voffB); PG8_STAGE(PG8_SA(1, 0), cA + kstep, voffA); PG8_STAGE(PG8_SB(1, 1), cB + hstep + kstep, voffB);
        PG8_WAIT_V(6); PG8_BAR;
    } else {
        PG8_STAGE(PG8_SB(0, 0), cB, voffB); PG8_STAGE(PG8_SA(0, 0), cA, voffA); PG8_STAGE(PG8_SB(0, 1), cB + hstep, voffB); PG8_STAGE(PG8_SA(0, 1), cA + hstep, voffA);
        if (wr == 1) PG8_BAR;
        PG8_WAIT_V(4); PG8_BAR;
        PG8_STAGE(PG8_SB(1, 0), cB + kstep, voffB); PG8_STAGE(PG8_SA(1, 0), cA + kstep, voffA); PG8_STAGE(PG8_SB(1, 1), cB + hstep + kstep, voffB);
        PG8_WAIT_V(6); PG8_BAR;
    }
    for (;;) {
        const bool has_next = S.next(ui + 1, nxt);
        const char* nA = has_next ? (const char*)g.A + (size_t)nxt.pm * tstep : cA; const char* nB = has_next ? (const char*)g.Bt + (size_t)nxt.pn * tstep : cB;
        for (int t = 0; t < nt; t += 2) {
            const bool last = (t == nt - 2);
            const char* a1 = cA + (size_t)(t + 1) * kstep;
            const char* a2 = last ? nA : cA + (size_t)(t + 2) * kstep; const char* b2 = last ? nB : cB + (size_t)(t + 2) * kstep;
            const char* a3 = a2 + kstep; const char* b3 = b2 + kstep;
            if (last && has_next) S.a_ready(nxt);
            if constexpr (SP2) {
            PG8_LDB(B0, 0, 0); PG8_LDB(B1, 0, 1); PG8_SCHED; PG8_LDA(At, 0, 0); PG8_STAGE(PG8_SA(1, 1), a1 + hstep, voffA);
            PG8_WAIT_V(8); PG8_WAIT_L(0); PG8_BAR; PG8_MMA(0, 0, At, B0); PG8_MMA(0, 1, At, B1); PG8_BAR; PG8_SCHED;
            PG8_LDA(At, 0, 1); PG8_STAGE(PG8_SB(0, 0), b2, voffB); PG8_STAGE(PG8_SB(0, 1), b2 + hstep, voffB); PG8_STAGE(PG8_SA(0, 0), a2, voffA);
            PG8_WAIT_V(8); PG8_WAIT_L(0); PG8_BAR; PG8_MMA(1, 0, At, B0); PG8_MMA(1, 1, At, B1); PG8_BAR; PG8_SCHED;
            PG8_LDB(B0, 1, 0); PG8_LDB(B1, 1, 1); PG8_SCHED; PG8_LDA(At, 1, 0); PG8_STAGE(PG8_SA(0, 1), a2 + hstep, voffA);
            PG8_WAIT_V(8); PG8_WAIT_L(0); PG8_BAR; PG8_MMA(0, 0, At, B0); PG8_MMA(0, 1, At, B1); PG8_BAR; PG8_SCHED;
            PG8_LDA(At, 1, 1); PG8_STAGE(PG8_SB(1, 0), b3, voffB); PG8_STAGE(PG8_SB(1, 1), b3 + hstep, voffB); PG8_STAGE(PG8_SA(1, 0), a3, voffA);
            PG8_WAIT_V(8); PG8_WAIT_L(0); PG8_BAR; PG8_MMA(1, 0, At, B0); PG8_MMA(1, 1, At, B1); PG8_BAR; PG8_SCHED;
            } else {
            PG8_LDB(B0, 0, 0); PG8_SCHED; PG8_LDA(At, 0, 0); PG8_STAGE(PG8_SA(1, 1), a1 + hstep, voffA);
            PG8_WAIT_L(8); PG8_BAR; PG8_WAIT_L(0); PG8_MMA(0, 0, At, B0); PG8_BAR; PG8_SCHED;
            PG8_LDB(B1, 0, 1); PG8_STAGE(PG8_SB(0, 0), b2, voffB);
            PG8_BAR; PG8_WAIT_L(0); PG8_MMA(0, 1, At, B1); PG8_BAR;
            PG8_LDA(At, 0, 1); PG8_STAGE(PG8_SA(0, 0), a2, voffA);
            PG8_BAR; PG8_WAIT_L(0); PG8_MMA(1, 0, At, B0); PG8_BAR; PG8_SCHED;
            PG8_STAGE(PG8_SB(0, 1), b2 + hstep, voffB);
            PG8_WAIT_V(6); PG8_BAR; PG8_MMA(1, 1, At, B1); PG8_BAR;
            PG8_LDB(B0, 1, 0); PG8_SCHED; PG8_LDA(At, 1, 0); PG8_STAGE(PG8_SA(0, 1), a2 + hstep, voffA);
            PG8_WAIT_L(8); PG8_BAR; PG8_WAIT_L(0); PG8_MMA(0, 0, At, B0); PG8_BAR; PG8_SCHED;
            PG8_LDB(B1, 1, 1); PG8_STAGE(PG8_SB(1, 0), b3, voffB);
            PG8_BAR; PG8_WAIT_L(0); PG8_MMA(0, 1, At, B1); PG8_BAR;
            PG8_LDA(At, 1, 1); PG8_STAGE(PG8_SA(1, 0), a3, voffA);
            PG8_BAR; PG8_WAIT_L(0); PG8_MMA(1, 0, At, B0); PG8_BAR; PG8_SCHED;
            PG8_STAGE(PG8_SB(1, 1), b3 + hstep, voffB);
            PG8_WAIT_V(6); PG8_BAR; PG8_MMA(1, 1, At, B1); PG8_BAR;
            }
        }
        if constexpr (ALIGN_EPI) { if (wr == 0) PG8_BAR; }
        if constexpr (!Epi::AFTER_DRAIN) { E(acc, cur, wr, wc, fr, fq); S.done(cur); }
        if (!has_next) break;
#pragma unroll
        for (int a = 0; a < 2; ++a)
#pragma unroll
            for (int b = 0; b < 2; ++b)
#pragma unroll
                for (int m = 0; m < 4; ++m)
#pragma unroll
                    for (int n = 0; n < 2; ++n) acc[a][b][m][n] = (f32x4){0.f, 0.f, 0.f, 0.f};
        cur = nxt; cA = nA; cB = nB; ++ui;
        if constexpr (ALIGN_EPI) { if (wr == 1) PG8_BAR; }
    }
    PG8_WAIT_V(0);
    if constexpr (!ALIGN_EPI) { if (wr == 0) PG8_BAR; }
    PG8_BAR;
    if constexpr (Epi::AFTER_DRAIN) { E.fused(acc, cur, wr, wc, fr, fq, lds, wid, lane); S.done(cur); }
#undef PG8_SA
#undef PG8_SB
#undef PG8_STAGE
#undef PG8_LDA
#undef PG8_LDB
#undef PG8_MMA
#undef PG8_WAIT_V
#undef PG8_WAIT_L
#undef PG8_BAR
#undef PG8_SCHED
}
}

typedef float v16f_t __attribute__((ext_vector_type(16)));
typedef float v32f_t __attribute__((ext_vector_type(32)));
typedef unsigned v6u_t __attribute__((ext_vector_type(6)));

__device__ __forceinline__ void transpose_item(const float* W, int K, int Nsrc, bf16* WT, float* scr, int kb, int nb, int lane) {
    const int k0 = 64 * kb, n0 = 32 * nb;
#pragma unroll 8
    for (int i = 0; i < 32; ++i) {
        const int kk = 2 * i + (lane >> 5), n = n0 + (lane & 31);
        scr[kk * 33 + (lane & 31)] = (n < Nsrc) ? W[(size_t)(k0 + kk) * Nsrc + n] : 0.f;
    }
    asm volatile("s_waitcnt lgkmcnt(0)" ::: "memory");
    const int c = lane & 7;
#pragma unroll
    for (int j = 0; j < 4; ++j) {
        const int n = (lane >> 3) + 8 * j;
        const float* s = scr + (8 * c) * 33 + n;
        uint4 o;
        o.x = pk2(s[0 * 33], s[1 * 33]); o.y = pk2(s[2 * 33], s[3 * 33]); o.z = pk2(s[4 * 33], s[5 * 33]); o.w = pk2(s[6 * 33], s[7 * 33]);
        *(uint4*)(WT + (size_t)(n0 + n) * K + k0 + 8 * c) = o;
    }
    asm volatile("s_waitcnt lgkmcnt(0)" ::: "memory");
}

__device__ __forceinline__ void norm_row_to_bf16(const float* xrow, const float* w, bf16* orow, int lane) {
    float v[16];
    const float4* xr = (const float4*)(xrow + 16 * lane);
    float ss = 0.f;
#pragma unroll
    for (int j = 0; j < 4; ++j) { float4 a = xr[j]; v[4 * j] = a.x; v[4 * j + 1] = a.y; v[4 * j + 2] = a.z; v[4 * j + 3] = a.w; ss += a.x * a.x + a.y * a.y + a.z * a.z + a.w * a.w; }
    const float rstd = rsqrtf(wave_sum(ss) * (1.f / D) + EPS);
    const float4* wr = (const float4*)(w + 16 * lane);
    uint4 o[2];
    unsigned* op = (unsigned*)o;
#pragma unroll
    for (int j = 0; j < 4; ++j) { float4 ww = wr[j]; op[2 * j] = pk2(v[4 * j] * rstd * ww.x, v[4 * j + 1] * rstd * ww.y); op[2 * j + 1] = pk2(v[4 * j + 2] * rstd * ww.z, v[4 * j + 3] * rstd * ww.w); }
    uint4* od = (uint4*)(orow + 16 * lane);
    od[0] = o[0]; od[1] = o[1];
}

__device__ __forceinline__ void ph_prep(const Params& p, float* lds, int tid, int lane, int wave) {
    float* scr = lds + wave * (64 * 33);
    const int gw = blockIdx.x * 8 + wave, NGW = gridDim.x * 8;
    const int gtid = blockIdx.x * NTHREADS + tid, GS = gridDim.x * NTHREADS;
    constexpr int I_IN = 16 * 96, I_OUT = 16 * 32, I_Q = 16 * 64, I_ALL = NL * (I_IN + I_OUT + I_Q);
    for (int it = gw; it < I_ALL; it += NGW) {
        int r = it; const int l = r / (I_IN + I_OUT + I_Q); r -= l * (I_IN + I_OUT + I_Q);
        if (r < I_IN) { transpose_item(p.w_in + (size_t)l * D * IN_DIM, D, IN_DIM, (bf16*)(p.ws + O_WIN) + (size_t)l * INP * D, scr, r / 96, r % 96, lane); continue; }
        r -= I_IN;
        if (r < I_OUT) { transpose_item(p.w_out + (size_t)l * D * D, D, D, (bf16*)(p.ws + O_WOUT) + (size_t)l * D * D, scr, r / 32, r % 32, lane); continue; }
        r -= I_OUT;
        transpose_item(p.peer_w_q + (size_t)l * D * 2048, D, 2048, (bf16*)(p.ws + O_WQ) + (size_t)l * 2048 * D, scr, r / 64, r % 64, lane);
    }
    for (int i = gtid; i < NL * 2 * 64 * 4 * 64; i += GS) {
        const int ln = i & 63, nt = (i >> 6) & 3, ksg = (i >> 8) & 63, tb = i >> 14;
        const float* W = p.nsa_cmp_w + (size_t)tb * 2048 * 64 + (size_t)(32 * ksg + 8 * (ln >> 4)) * 64 + 16 * nt + (ln & 15);
        uint4 o; o.x = pk2(W[0], W[64]); o.y = pk2(W[128], W[192]); o.z = pk2(W[256], W[320]); o.w = pk2(W[384], W[448]);
        ((uint4*)(p.ws + O_WCT))[i] = o;
    }
    for (int it = gw; it < NL * 2 * 64; it += NGW) {
        const int tb = it >> 6, n = it & 63; const float* W = p.nsa_cmp_w + (size_t)tb * 2048 * 64; const float* ps = p.nsa_cmp_pos + (size_t)tb * 2048;
        float a = 0.f;
#pragma unroll 8
        for (int j = 0; j < 32; ++j) a += ps[lane + 64 * j] * W[(size_t)(lane + 64 * j) * 64 + n];
        a = wave_sum(a);
        if (lane == 0) ((float*)(p.ws + O_PBIAS))[it] = a; }
    for (int rp = gw * 2; rp < NL * 16384 / 2; rp += NGW * 2) {
        v16f_t x[2][2][2];
#pragma unroll
        for (int tb = 0; tb < 2; ++tb)
#pragma unroll
            for (int q = 0; q < 2; ++q) { const int row = 2 * (rp + q) + (lane >> 5);
                const pg8::f32x4* srow = (const pg8::f32x4*)((tb ? p.peer_v : p.peer_u) + (size_t)row * 1024 + 4 * (lane & 31));
#pragma unroll
                for (int j = 0; j < 8; ++j) { const pg8::f32x4 a = __builtin_nontemporal_load(srow + 32 * j);
                    x[tb][q][0][2 * j] = a[0]; x[tb][q][1][2 * j] = a[1]; x[tb][q][0][2 * j + 1] = a[2]; x[tb][q][1][2 * j + 1] = a[3]; } }
#pragma unroll
        for (int tb = 0; tb < 2; ++tb)
#pragma unroll
            for (int q = 0; q < 2; ++q) { const int row = 2 * (rp + q) + (lane >> 5);
                float am = 0.f;
#pragma unroll
                for (int j = 0; j < 16; ++j) am = fmaxf(am, fmaxf(fabsf(x[tb][q][0][j]), fabsf(x[tb][q][1][j])));
#pragma unroll
                for (int o = 1; o < 32; o <<= 1) am = fmaxf(am, __shfl_xor(am, o));
                const float sc = (am > 0.f) ? 7.0f / am : 0.f;
                const v6u_t pk = __builtin_amdgcn_cvt_scalef32_2xpk16_fp6_f32(x[tb][q][0] * sc, x[tb][q][1] * sc, 1.0f);
                unsigned char* rowp = p.ws + (tb ? O_VT : O_UT) + (size_t)row * 1024; const int q32 = lane & 31, li_ = q32 >> 1;
                if ((q32 & 1) == 0) { *(uint4*)(rowp + li_ * 16) = make_uint4(pk[0], pk[1], pk[2], pk[3]); *(uint2*)(rowp + 256 + li_ * 16) = make_uint2(pk[4], pk[5]); }
                else { *(uint2*)(rowp + 256 + li_ * 16 + 8) = make_uint2(pk[0], pk[1]); *(uint4*)(rowp + 512 + li_ * 16) = make_uint4(pk[2], pk[3], pk[4], pk[5]); }
                if ((lane & 31) == 0) ((float*)(p.ws + (tb ? O_VSC : O_USC)))[row] = am * (1.f / 7.0f); }
    }
    for (int i = gtid; i < NL * 2 * 128 * 128 / 8; i += GS) { const float4 a = ((const float4*)p.peer_sub_keys)[2 * i], b4 = ((const float4*)p.peer_sub_keys)[2 * i + 1];
        uint4 o; o.x = pk2(a.x, a.y); o.y = pk2(a.z, a.w); o.z = pk2(b4.x, b4.y); o.w = pk2(b4.z, b4.w); ((uint4*)(p.ws + O_KYB))[i] = o; }
    {
        float* rc = (float*)(p.ws + O_ROPE); float* rs = rc + SEQ * 8;
        for (int i = gtid; i < SEQ * 8; i += GS) {
            const int pos = i >> 3, k = i & 7;
            const float invf = (k == 0) ? 1.0f : (k == 1) ? 1.9392274e-01f : (k == 2) ? 3.7606031e-02f : (k == 3) ? 7.2926646e-03f : (k == 4) ? 1.4142136e-03f : (k == 5) ? 2.7424819e-04f : (k == 6) ? 5.3182961e-05f : 1.0313386e-05f;
            const float ang = (float)pos * invf;
            rc[i] = cosf(ang); rs[i] = sinf(ang);
        }
    }
    for (int m = gw; m < T; m += NGW) norm_row_to_bf16(p.x + (size_t)m * D, p.norm1_w, (bf16*)(p.ws + O_H1) + (size_t)m * D, lane);
}

typedef short s16x8 __attribute__((ext_vector_type(8)));
typedef float f32x4v __attribute__((ext_vector_type(4)));
#define MFMA16(a, b, c) __builtin_amdgcn_mfma_f32_16x16x32_bf16((a), (b), (c), 0, 0, 0)
__device__ __forceinline__ s16x8 ldfrag(const bf16* base, int stride, int row0, int k0, int lane) {
    return *(const s16x8*)(base + (row0 + (lane & 15)) * stride + k0 + 8 * (lane >> 4));
}
__device__ __forceinline__ s16x8 ldfrag_perm(const bf16* base, int stride, int row0, int k0, int lane) {
    const bf16* p = base + (row0 + (lane & 15)) * stride + k0 + 4 * (lane >> 4);
    const uint2 a = *(const uint2*)p, b = *(const uint2*)(p + 16);
    return __builtin_bit_cast(s16x8, make_uint4(a.x, a.y, b.x, b.y));
}
template <int CTRL> __device__ __forceinline__ float dpp_f(float v) { return __builtin_bit_cast(float, __builtin_amdgcn_update_dpp(0, __builtin_bit_cast(int, v), CTRL, 0xf, 0xf, true)); }
__device__ __forceinline__ float suffix16(float v) { v += dpp_f<0x101>(v); v += dpp_f<0x102>(v); v += dpp_f<0x104>(v); v += dpp_f<0x108>(v); return v; }
__device__ __forceinline__ float rowsum16(float v) { v += dpp_f<0x128>(v); v += dpp_f<0x124>(v); v += dpp_f<0x122>(v); v += dpp_f<0x121>(v); return v; }
__device__ __forceinline__ float rowmax16(float v) { v = fmaxf(v, dpp_f<0x128>(v)); v = fmaxf(v, dpp_f<0x124>(v)); v = fmaxf(v, dpp_f<0x122>(v)); v = fmaxf(v, dpp_f<0x121>(v)); return v; }
#define LDS_FENCE() asm volatile("s_waitcnt lgkmcnt(0)" ::: "memory")

__device__ __forceinline__ void ph_elem(const Params& p, int l, int tid) {
    const int gtid = blockIdx.x * NTHREADS + tid, GS = gridDim.x * NTHREADS;
    const bf16* PROJ = (const bf16*)(p.ws + O_PROJ);
    const float* rc = (const float*)(p.ws + O_ROPE); const float* rs = rc + SEQ * 8;
    const int c8 = tid & 7;
    for (int idx = gtid >> 3; idx < T * 6; idx += GS >> 3) {
        const int t = idx / 6, j = idx - t * 6, s = t & (SEQ - 1);
        const bf16* src = PROJ + (size_t)t * INP + ((j < 4) ? (C_NQ + 64 * j) : (j == 4) ? (C_NKV + 128) : (C_NKV + 256));
        float v[8]; unpack8(((const uint4*)src)[c8], v);
        const float* w = ((j < 4) ? (p.nsa_q_norm_w + l * 64) : (p.nsa_k_norm_w + (size_t)l * 192 + ((j == 4) ? 64 : 128))) + 8 * c8;
        float ss = 0.f;
#pragma unroll
        for (int d = 0; d < 8; ++d) ss += v[d] * v[d];
        ss += __shfl_xor(ss, 1); ss += __shfl_xor(ss, 2); ss += __shfl_xor(ss, 4);
        const float rstd = rsqrtf(ss * (1.f / 64.f) + EPS);
#pragma unroll
        for (int d = 0; d < 8; ++d) v[d] = v[d] * rstd * w[d];
        float oth[8];
#pragma unroll
        for (int d = 0; d < 8; ++d) oth[d] = __shfl_xor(v[d], 1);
        if (c8 < 2) {
#pragma unroll
            for (int d = 0; d < 8; ++d) { const float c = rc[s * 8 + d], sn = rs[s * 8 + d]; v[d] = (c8 == 0) ? (v[d] * c - oth[d] * sn) : (v[d] * c + oth[d] * sn); } }
        bf16* dst = (j < 4) ? ((bf16*)(p.ws + O_QN) + (size_t)t * 256 + 64 * j) : (j == 4) ? ((bf16*)(p.ws + O_KS) + (size_t)t * 64) : ((bf16*)(p.ws + O_KW) + (size_t)t * 64);
        uint4 o; o.x = pk2(v[0], v[1]); o.y = pk2(v[2], v[3]); o.z = pk2(v[4], v[5]); o.w = pk2(v[6], v[7]);
        ((uint4*)dst)[c8] = o;
    }
}

__device__ __forceinline__ void ph_cmp_kv_fast(const Params& p, int l, unsigned char* smem, int tid, int lane, int wave, int item0, int istride) {
    const bf16* PROJ = (const bf16*)(p.ws + O_PROJ);
    bf16* KCMP = (bf16*)(p.ws + O_KCMP); bf16* VCMP = (bf16*)(p.ws + O_VCMP);
    const float* rc = (const float*)(p.ws + O_ROPE); const float* rs = rc + SEQ * 8;
    float* RED = (float*)smem;
    const int fr = lane & 15, fq = lane >> 4;
    for (int it = item0; it < BATCH * 2 * 8; it += istride) {
        const int rt = it & 7, kv = (it >> 3) & 1, b = it >> 4;
        const bf16* W2 = (const bf16*)(p.ws + O_WCT) + ((size_t)l * 2 + kv) * 64 * 2048;
        const int c = 16 * rt + fr;
        const int cc = (c > 126) ? 126 : c;
        const bf16* abase = PROJ + ((size_t)b * SEQ + 16 * cc) * INP + C_NKV + (kv ? 64 : 0);
        f32x4v acc[4];
#pragma unroll
        for (int nt = 0; nt < 4; ++nt) acc[nt] = (f32x4v){0.f, 0.f, 0.f, 0.f};
#pragma unroll
        for (int ii = 0; ii < 4; ++ii) {
            const int i = 4 * wave + ii;
            const bf16* ar = abase + (size_t)i * INP;
            s16x8 a0 = *(const s16x8*)(ar + 8 * fq), a1 = *(const s16x8*)(ar + 32 + 8 * fq);
            if (kv == 0 && fq < 2) {
                const int pos = 16 * cc + i;
                float own[8], oth[8]; unpack8(__builtin_bit_cast(uint4, a0), own); unpack8(*(const uint4*)(ar + 8 * (fq ^ 1)), oth);
                float o8[8];
#pragma unroll
                for (int e = 0; e < 8; ++e) { const float cs = rc[pos * 8 + e], sn = rs[pos * 8 + e];
                    o8[e] = (fq == 0) ? (own[e] * cs - oth[e] * sn) : (own[e] * cs + oth[e] * sn); }
                uint4 u; u.x = pk2(o8[0], o8[1]); u.y = pk2(o8[2], o8[3]); u.z = pk2(o8[4], o8[5]); u.w = pk2(o8[6], o8[7]);
                a0 = __builtin_bit_cast(s16x8, u);
            }
#pragma unroll
            for (int nt = 0; nt < 4; ++nt) {
                const bf16* wr = W2 + ((size_t)((2 * i) * 4 + nt) * 64 + lane) * 8;
                acc[nt] = MFMA16(a0, *(const s16x8*)wr, acc[nt]);
                acc[nt] = MFMA16(a1, *(const s16x8*)(wr + 4 * 64 * 8), acc[nt]);
            }
        }
        __syncthreads();
#pragma unroll
        for (int nt = 0; nt < 4; ++nt)
#pragma unroll
            for (int r = 0; r < 4; ++r) RED[(wave * 16 + 4 * fq + r) * 64 + 16 * nt + fr] = acc[nt][r];
        __syncthreads();
        {
            const int row = tid >> 5, c0 = 2 * (tid & 31);
            const float* pb = (const float*)(p.ws + O_PBIAS) + ((size_t)l * 2 + kv) * 64;
            float v0 = pb[c0], v1 = pb[c0 + 1];
#pragma unroll
            for (int w = 0; w < 8; ++w) { v0 += RED[(w * 16 + row) * 64 + c0]; v1 += RED[(w * 16 + row) * 64 + c0 + 1]; }
            float ss = v0 * v0 + v1 * v1;
#pragma unroll
            for (int o = 1; o < 32; o <<= 1) ss += __shfl_xor(ss, o);
            const int crow = 16 * rt + row;
            if (kv == 0) { const float rstd = rsqrtf(ss * (1.f / 64.f) + EPS); v0 *= rstd * p.nsa_k_norm_w[l * 192 + c0]; v1 *= rstd * p.nsa_k_norm_w[l * 192 + c0 + 1]; }
            if (crow == 127) { v0 = 0.f; v1 = 0.f; }
            *(unsigned*)(((kv == 0) ? KCMP : VCMP) + ((size_t)b * 128 + crow) * 64 + c0) = pk2(v0, v1);
        }
    }
}

__device__ __forceinline__ void ph_ssd_p1(const Params& p, int l, unsigned char* smem, int tid, int lane, int wave, int item0, int istride) {
    constexpr int ST = 136;
    bf16* BT = (bf16*)smem;
    bf16* XdT = BT + 128 * ST;
    float* Acs = (float*)(XdT + 4 * 64 * ST);
    float* dts = Acs + 512;
    float* Araw = dts + 512;
    const bf16* PROJ = (const bf16*)(p.ws + O_PROJ); bf16* XBC = (bf16*)(p.ws + O_XBC); float* DT = (float*)(p.ws + O_DT);
    float* SLOC = (float*)(p.ws + O_SLOC); float* ATOT = (float*)(p.ws + O_ATOT);
    const float* cw = p.conv_w + (size_t)l * 4 * 1024; const float* cb = p.conv_b + (size_t)l * 1024;
    const int fr = lane & 15, fq = lane >> 4;
    for (int item = item0; item < BATCH * 16 * 2; item += istride) {
        const int g = item & 1, c = (item >> 1) & 15, b = item >> 5;
        const size_t t0 = (size_t)b * SEQ + 128 * c;
        __syncthreads();
        {   const int hh = tid >> 7, lrow = tid & 127, h = 4 * g + hh;
            const float dt = softplusf(bf2f(PROJ[(t0 + lrow) * INP + C_DT + h]) + p.dt_bias[l * 8 + h]);
            DT[(t0 + lrow) * 8 + h] = dt; dts[tid] = dt; Araw[tid] = dt * (-fexp(p.a_log[l * 8 + h])); }
        __syncthreads();
        {   const int hh = tid >> 7, lrow = tid & 127; float s = 0.f;
            for (int k = 0; k <= lrow; ++k) s += Araw[hh * 128 + k];
            Acs[tid] = s;
            if (lrow == 127) ATOT[((size_t)b * 16 + c) * 8 + 4 * g + hh] = s; }
        __syncthreads();
#pragma unroll 1
        for (int i4 = 0; i4 < 4; ++i4) {
            uint4 tap[4][4];
#pragma unroll
            for (int u = 0; u < 4; ++u) { const int idx = tid + NTHREADS * (4 * i4 + u), row = idx >> 6, cg = idx & 63;
                const int col = (cg < 32) ? (g * 256 + 8 * cg) : (cg < 48) ? (512 + g * 128 + 8 * (cg - 32)) : (768 + g * 128 + 8 * (cg - 48));
#pragma unroll
                for (int k = 0; k < 4; ++k) { const int ts = 128 * c + row - 3 + k;
                    tap[u][k] = (ts >= 0) ? *(const uint4*)(PROJ + (t0 + row - 3 + k) * INP + C_XBC + col) : make_uint4(0u, 0u, 0u, 0u); } }
#pragma unroll
            for (int u = 0; u < 4; ++u) {
            const int idx = tid + NTHREADS * (4 * i4 + u), row = idx >> 6, cg = idx & 63;
            const int col = (cg < 32) ? (g * 256 + 8 * cg) : (cg < 48) ? (512 + g * 128 + 8 * (cg - 32)) : (768 + g * 128 + 8 * (cg - 48));
            float acc[8];
            { const float4 b0 = *(const float4*)(cb + col), b1 = *(const float4*)(cb + col + 4); acc[0] = b0.x; acc[1] = b0.y; acc[2] = b0.z; acc[3] = b0.w; acc[4] = b1.x; acc[5] = b1.y; acc[6] = b1.z; acc[7] = b1.w; }
#pragma unroll
            for (int k = 0; k < 4; ++k) { float f[8]; unpack8(tap[u][k], f);
                const float4 w0 = *(const float4*)(cw + k * 1024 + col), w1 = *(const float4*)(cw + k * 1024 + col + 4);
                acc[0] += w0.x * f[0]; acc[1] += w0.y * f[1]; acc[2] += w0.z * f[2]; acc[3] += w0.w * f[3]; acc[4] += w1.x * f[4]; acc[5] += w1.y * f[5]; acc[6] += w1.z * f[6]; acc[7] += w1.w * f[7]; }
#pragma unroll
            for (int e = 0; e < 8; ++e) acc[e] = siluf(acc[e]);
            uint4 o; o.x = pk2(acc[0], acc[1]); o.y = pk2(acc[2], acc[3]); o.z = pk2(acc[4], acc[5]); o.w = pk2(acc[6], acc[7]);
            *(uint4*)(XBC + (t0 + row) * 1024 + col) = o;
            float f[8]; unpack8(o, f);
            if (cg < 32) { const int hh = cg >> 3, p0 = (8 * cg) & 63; const float sc = dts[hh * 128 + row] * fexp(Acs[hh * 128 + 127] - Acs[hh * 128 + row]);
#pragma unroll
                for (int e = 0; e < 8; ++e) XdT[(hh * 64 + p0 + e) * ST + row] = f2bf(f[e] * sc); }
            else if (cg < 48) { const int n0 = 8 * (cg - 32);
#pragma unroll
                for (int e = 0; e < 8; ++e) BT[(n0 + e) * ST + row] = f2bf(f[e]); }
            }
        }
        __syncthreads();
        {
            const int hh = wave >> 1, ntb = 4 * (wave & 1), h = 4 * g + hh;
            float* dst = SLOC + (((size_t)b * 16 + c) * 8 + h) * 8192;
#pragma unroll
            for (int mt = 0; mt < 4; ++mt) {
                s16x8 xf[4];
#pragma unroll
                for (int ks = 0; ks < 4; ++ks) xf[ks] = ldfrag(XdT + hh * 64 * ST, ST, 16 * mt, 32 * ks, lane);
#pragma unroll
                for (int j = 0; j < 4; ++j) { f32x4v a = {0.f, 0.f, 0.f, 0.f};
#pragma unroll
                    for (int ks = 0; ks < 4; ++ks) a = MFMA16(ldfrag(BT, ST, 16 * (ntb + j), 32 * ks, lane), xf[ks], a);
                    *(f32x4v*)(dst + (16 * mt + fr) * 128 + 16 * (ntb + j) + 4 * fq) = a; }
            }
        }
    }
}
__device__ __forceinline__ void ph_ssd_scan(const Params& p, int tid) {
    const int gtid = blockIdx.x * NTHREADS + tid, GS = gridDim.x * NTHREADS;
    const float* SLOC = (const float*)(p.ws + O_SLOC); const float* ATOT = (const float*)(p.ws + O_ATOT); bf16* SIN = (bf16*)(p.ws + O_SIN);
    for (int i = gtid; i < BATCH * 8 * 2048; i += GS) {
        const int e4 = i & 2047, h = (i >> 11) & 7, b = i >> 14;
        float4 v[15]; float at[15];
#pragma unroll
        for (int c = 0; c < 15; ++c) { v[c] = *(const float4*)(SLOC + (((size_t)b * 16 + c) * 8 + h) * 8192 + 4 * e4); at[c] = ATOT[((size_t)b * 16 + c) * 8 + h]; }
        float4 s = {0.f, 0.f, 0.f, 0.f};
        *(uint2*)(SIN + (((size_t)b * 16 + 0) * 8 + h) * 8192 + 4 * e4) = make_uint2(0u, 0u);
#pragma unroll
        for (int c = 0; c < 15; ++c) { const float w = fexp(at[c]); s.x = s.x * w + v[c].x; s.y = s.y * w + v[c].y; s.z = s.z * w + v[c].z; s.w = s.w * w + v[c].w;
            *(uint2*)(SIN + (((size_t)b * 16 + c + 1) * 8 + h) * 8192 + 4 * e4) = make_uint2(pk2(s.x, s.y), pk2(s.z, s.w)); }
    }
}
__device__ __forceinline__ void ph_ssd_p2(const Params& p, int l, unsigned char* smem, int tid, int lane, int wave, int item0, int istride) {
    constexpr int ST = 136;
    bf16* Cs = (bf16*)smem; bf16* Bs = Cs + 128 * ST; bf16* XT = Bs + 128 * ST; bf16* Ss = XT + 64 * ST;
    float* Acs = (float*)(Ss + 64 * ST); float* dts = Acs + 512; float* Araw = dts + 512;
    const bf16* PROJ = (const bf16*)(p.ws + O_PROJ); const bf16* XBC = (const bf16*)(p.ws + O_XBC); const float* DT = (const float*)(p.ws + O_DT);
    const float* SLOC = (const float*)(p.ws + O_SLOC); const float* ATOT = (const float*)(p.ws + O_ATOT);
    bf16* MIX = (bf16*)(p.ws + O_MIX);
    const int fr = lane & 15, fq = lane >> 4;
    for (int item = item0; item < BATCH * 16 * 2; item += istride) {
        const int g = item & 1, c = 15 - ((item >> 1) & 15), b = item >> 5;
        const size_t t0 = (size_t)b * SEQ + 128 * c;
        __syncthreads();
#pragma unroll
        for (int i = 0; i < 4; ++i) { const int idx = tid + NTHREADS * i, row = idx >> 4, c16 = idx & 15;
            *(uint4*)(Cs + row * ST + 8 * c16) = *(const uint4*)(XBC + (t0 + row) * 1024 + 768 + g * 128 + 8 * c16);
            *(uint4*)(Bs + row * ST + 8 * c16) = *(const uint4*)(XBC + (t0 + row) * 1024 + 512 + g * 128 + 8 * c16); }
        {   const int hh = tid >> 7, lrow = tid & 127, h = 4 * g + hh; const float dt = DT[(t0 + lrow) * 8 + h];
            dts[tid] = dt; Araw[tid] = dt * (-fexp(p.a_log[l * 8 + h])); }
        __syncthreads();
        {   const int hh = tid >> 7, lrow = tid & 127; float s = 0.f;
            for (int k = 0; k <= lrow; ++k) s += Araw[hh * 128 + k];
            Acs[tid] = s; }
        s16x8 af[4];
#pragma unroll
        for (int ks = 0; ks < 4; ++ks) af[ks] = ldfrag(Cs, ST, 16 * wave, 32 * ks, lane);
        f32x4v gacc[8];
#pragma unroll
        for (int st = 0; st < 8; ++st) { gacc[st] = (f32x4v){0.f, 0.f, 0.f, 0.f};
            if (st <= wave) {
#pragma unroll
                for (int ks = 0; ks < 4; ++ks) gacc[st] = MFMA16(af[ks], ldfrag(Bs, ST, 16 * st, 32 * ks, lane), gacc[st]); } }
#pragma unroll 1
        for (int hh = 0; hh < 4; ++hh) {
            const int h = 4 * g + hh;
            __syncthreads();
            {
                const uint4* s4 = (const uint4*)((const bf16*)(p.ws + O_SIN) + (((size_t)b * 16 + c) * 8 + h) * 8192 + tid * 16);
                const uint4 o0 = s4[0], o1 = s4[1];
                *(uint4*)(Ss + (tid >> 3) * ST + 16 * (tid & 7)) = o0; *(uint4*)(Ss + (tid >> 3) * ST + 16 * (tid & 7) + 8) = o1;
            }
#pragma unroll
            for (int i = 0; i < 2; ++i) { const int idx = tid + NTHREADS * i, row = idx >> 3, c8 = idx & 7;
                float f[8]; unpack8(*(const uint4*)(XBC + (t0 + row) * 1024 + h * 64 + 8 * c8), f); const float dt = dts[hh * 128 + row];
#pragma unroll
                for (int e = 0; e < 8; ++e) XT[(8 * c8 + e) * ST + row] = f2bf(f[e] * dt); }
            float acl[4];
#pragma unroll
            for (int r = 0; r < 4; ++r) acl[r] = Acs[hh * 128 + 16 * wave + 4 * fq + r];
            {
                bf16* Ms = Bs;
#pragma unroll
                for (int st = 0; st < 8; ++st) { if (st <= (wave | 1)) {
                    const int s = 16 * st + fr; const float acs_s = Acs[hh * 128 + s];
#pragma unroll
                    for (int r = 0; r < 4; ++r) { const int lrow = 16 * wave + 4 * fq + r;
                        const float v = (s <= lrow) ? gacc[st][r] * fexp(acl[r] - acs_s) : 0.f;
                        Ms[lrow * ST + s] = f2bf(v); } } }
            }
            __syncthreads();
            {
                const bf16* Ms = Bs;
                f32x4v yd[4], yo[4];
#pragma unroll
                for (int pt = 0; pt < 4; ++pt) { yd[pt] = (f32x4v){0.f, 0.f, 0.f, 0.f}; yo[pt] = (f32x4v){0.f, 0.f, 0.f, 0.f}; }
                const size_t t = t0 + 16 * wave + fr;
                uint2 xqa[4], zqa[4];
#pragma unroll
                for (int pt = 0; pt < 4; ++pt) { const int col = h * 64 + 16 * pt + 4 * fq; xqa[pt] = *(const uint2*)(XBC + t * 1024 + col); zqa[pt] = *(const uint2*)(PROJ + t * INP + C_Z + col); }
#pragma unroll
                for (int ks = 0; ks < 4; ++ks) {
                    if (2 * ks <= wave) { const s16x8 mf = ldfrag(Ms, ST, 16 * wave, 32 * ks, lane);
#pragma unroll
                        for (int pt = 0; pt < 4; ++pt) yd[pt] = MFMA16(ldfrag(XT, ST, 16 * pt, 32 * ks, lane), mf, yd[pt]); }
#pragma unroll
                    for (int pt = 0; pt < 4; ++pt) yo[pt] = MFMA16(ldfrag(Ss, ST, 16 * pt, 32 * ks, lane), af[ks], yo[pt]); }
                const float dsk = p.d_skip[l * 8 + h];
                const float ea = fexp(Acs[hh * 128 + 16 * wave + fr]);
#pragma unroll
                for (int pt = 0; pt < 4; ++pt) { const int col = h * 64 + 16 * pt + 4 * fq;
                    const uint2 xq = xqa[pt], zq = zqa[pt];
                    const float xs[4] = {__uint_as_float(xq.x << 16), __uint_as_float(xq.x & 0xffff0000u), __uint_as_float(xq.y << 16), __uint_as_float(xq.y & 0xffff0000u)};
                    const float zz[4] = {__uint_as_float(zq.x << 16), __uint_as_float(zq.x & 0xffff0000u), __uint_as_float(zq.y << 16), __uint_as_float(zq.y & 0xffff0000u)};
                    float y[4];
#pragma unroll
                    for (int e = 0; e < 4; ++e) y[e] = (yd[pt][e] + ea * yo[pt][e] + dsk * xs[e]) * siluf(zz[e]);
                    *(uint2*)(MIX + t * 1024 + col) = make_uint2(pk2(y[0], y[1]), pk2(y[2], y[3])); }
            }
        }
    }
}

#ifndef SB_EXIT_THR
#define SB_EXIT_THR (-80.f)
#endif
__device__ __forceinline__ void ph_sb_fast(const Params& p, unsigned char* smem, int tid, int lane, int wave, int item0, int istride) {
    constexpr int ST = 72;
    bf16* Ks = (bf16*)smem; bf16* VT = Ks + 64 * ST; volatile int* FLG = (volatile int*)(VT + 64 * ST);
    const bf16* PROJ = (const bf16*)(p.ws + O_PROJ); bf16* MIX = (bf16*)(p.ws + O_MIX);
    const int fr = lane & 15, fq = lane >> 4;
    for (int item = item0; item < BATCH * 4 * 16; item += istride) {
        const int qt = 15 - (item & 15), h = (item >> 4) & 3, b = item >> 6;
        const size_t rowb = (size_t)b * SEQ;
        s16x8 qf[2];
#pragma unroll
        for (int ks = 0; ks < 2; ++ks) qf[ks] = *(const s16x8*)(PROJ + (rowb + 128 * qt + 16 * wave + fr) * INP + C_SB + h * 64 + 32 * ks + 8 * fq);
        const int t = 128 * qt + 16 * wave + fr;
        f32x4v o[4];
#pragma unroll
        for (int dt = 0; dt < 4; ++dt) o[dt] = (f32x4v){0.f, 0.f, 0.f, 0.f};
        float R = 0.f;
        if (tid == 0) { FLG[0] = 0; FLG[1] = 0; }
        uint4 nk, nv;
        { const bf16* src = PROJ + (rowb + 64 * (2 * qt + 1) + (tid >> 3)) * INP + C_SB + 256 + h * 64 + 8 * (tid & 7); nk = *(const uint4*)src; nv = *(const uint4*)(src + 256); }
        int itn = 0;
#pragma unroll 1
        for (int kt = 2 * qt + 1; kt >= 0; --kt, ++itn) {
            __syncthreads();
            if (itn > 0 && FLG[(itn - 1) & 1] == 0) break;
            if (tid == 0) FLG[itn & 1] = 0;
            {
                const int row = tid >> 3, c8 = tid & 7;
                const uint4 kv = nk, vv = nv;
                *(uint4*)(Ks + row * ST + 8 * c8) = kv;
                const unsigned vw[4] = {vv.x, vv.y, vv.z, vv.w};
#pragma unroll
                for (int e = 0; e < 8; ++e) VT[(8 * c8 + e) * ST + row] = (bf16)((e & 1) ? (vw[e >> 1] >> 16) : (vw[e >> 1] & 0xffffu));
            }
            __syncthreads();
            if (kt > 0) { const bf16* src = PROJ + (rowb + 64 * (kt - 1) + (tid >> 3)) * INP + C_SB + 256 + h * 64 + 8 * (tid & 7); nk = *(const uint4*)src; nv = *(const uint4*)(src + 256); }
            f32x4v st[4];
#pragma unroll
            for (int mt = 0; mt < 4; ++mt) { st[mt] = (f32x4v){0.f, 0.f, 0.f, 0.f};
#pragma unroll
                for (int ks = 0; ks < 2; ++ks) st[mt] = MFMA16(ldfrag(Ks, ST, 16 * mt, 32 * ks, lane), qf[ks], st[mt]); }
            float z[16], ls[16], T[4], E[4], C[4];
#pragma unroll
            for (int mt = 0; mt < 4; ++mt) { T[mt] = 0.f;
#pragma unroll
                for (int r = 0; r < 4; ++r) { const int key = 64 * kt + 16 * mt + 4 * fq + r; z[4 * mt + r] = st[mt][r] * 0.125f;
                    ls[4 * mt + r] = (key < t) ? -softplus_fast(z[4 * mt + r]) : 0.f; T[mt] += ls[4 * mt + r]; }
                const float a1 = __shfl_xor(T[mt], 16), a2 = __shfl_xor(T[mt], 32), a3 = __shfl_xor(a1, 32);
                E[mt] = (((fq ^ 1) > fq) ? a1 : 0.f) + (((fq ^ 2) > fq) ? a2 : 0.f) + (((fq ^ 3) > fq) ? a3 : 0.f);
                C[mt] = T[mt] + a1 + a2 + a3; }
            unsigned pw[8];
            {
                float base = R;
#pragma unroll
                for (int mt = 3; mt >= 0; --mt) { float inl = base + E[mt]; float wv[4];
#pragma unroll
                    for (int r = 3; r >= 0; --r) { const int key = 64 * kt + 16 * mt + 4 * fq + r; inl += ls[4 * mt + r];
                        wv[r] = (key < t) ? fexp(z[4 * mt + r] + inl) : 0.f; }
                    pw[2 * mt] = pk2(wv[0], wv[1]); pw[2 * mt + 1] = pk2(wv[2], wv[3]);
                    base += C[mt]; }
                R = base;
            }
#pragma unroll
            for (int s2 = 0; s2 < 2; ++s2) { const s16x8 pb = __builtin_bit_cast(s16x8, make_uint4(pw[4 * s2], pw[4 * s2 + 1], pw[4 * s2 + 2], pw[4 * s2 + 3]));
#pragma unroll
                for (int dt = 0; dt < 4; ++dt) o[dt] = MFMA16(ldfrag_perm(VT, ST, 16 * dt, 32 * s2, lane), pb, o[dt]); }
            const int done = (R < SB_EXIT_THR) ? 1 : 0;
            if (!__all(done) && lane == 0) FLG[itn & 1] = 1;
        }
#pragma unroll
        for (int dt = 0; dt < 4; ++dt) *(uint2*)(MIX + (rowb + t) * 1024 + 512 + h * 64 + 16 * dt + 4 * fq) = make_uint2(pk2(o[dt][0], o[dt][1]), pk2(o[dt][2], o[dt][3]));
        __syncthreads();
    }
}

struct NsaLds { bf16* Ks; bf16* VT; bf16* Ps; float* PF; float* IMP; unsigned char* SELB; };
__device__ __forceinline__ void nsa_load(uint4& kv, uint4& vv, const bf16* kbase, int kst, const bf16* vbase, int vst, int tid) {
    const int row = tid >> 3, c8 = tid & 7;
    kv = *(const uint4*)(kbase + (size_t)row * kst + 8 * c8); vv = *(const uint4*)(vbase + (size_t)row * vst + 8 * c8);
}
__device__ __forceinline__ void nsa_store(bf16* Ks, bf16* VT, const uint4& kv, const uint4& vv, int tid) {
    const int row = tid >> 3, c8 = tid & 7;
    *(uint4*)(Ks + row * 72 + 8 * c8) = kv;
    const unsigned vw[4] = {vv.x, vv.y, vv.z, vv.w};
#pragma unroll
    for (int e = 0; e < 8; ++e) VT[(8 * c8 + e) * 136 + row] = (bf16)((e & 1) ? (vw[e >> 1] >> 16) : (vw[e >> 1] & 0xffffu));
}
template <class Mask>
__device__ __forceinline__ void nsa_tile_t(const bf16* Ks, const bf16* VT, const s16x8 (&qf)[2], f32x4v (&ot)[4], float& m, float& lpart, int lane, const Mask& allowed) {
    const int fq = lane >> 4;
    f32x4v st[4];
#pragma unroll
    for (int mt = 0; mt < 4; ++mt) { st[mt] = (f32x4v){0.f, 0.f, 0.f, 0.f};
#pragma unroll
        for (int ks = 0; ks < 2; ++ks) st[mt] = MFMA16(ldfrag(Ks, 72, 16 * mt, 32 * ks, lane), qf[ks], st[mt]); }
    float sv[16]; bool ok[16]; float tm = -1e30f;
#pragma unroll
    for (int mt = 0; mt < 4; ++mt)
#pragma unroll
        for (int r = 0; r < 4; ++r) { sv[4 * mt + r] = st[mt][r] * 0.125f; ok[4 * mt + r] = allowed(16 * mt + 4 * fq + r); tm = fmaxf(tm, ok[4 * mt + r] ? sv[4 * mt + r] : -1e30f); }
    tm = fmaxf(tm, __shfl_xor(tm, 16)); tm = fmaxf(tm, __shfl_xor(tm, 32));
    const float mn = fmaxf(m, tm), alpha = fexp(m - mn); m = mn;
    float ps = 0.f; unsigned pw[8];
#pragma unroll
    for (int mt = 0; mt < 4; ++mt) { float pv[4];
#pragma unroll
        for (int r = 0; r < 4; ++r) { pv[r] = ok[4 * mt + r] ? fexp(sv[4 * mt + r] - mn) : 0.f; ps += pv[r]; }
        pw[2 * mt] = pk2(pv[0], pv[1]); pw[2 * mt + 1] = pk2(pv[2], pv[3]); }
    lpart = lpart * alpha + ps;
#pragma unroll
    for (int dt = 0; dt < 4; ++dt) ot[dt] = ot[dt] * alpha;
#pragma unroll
    for (int s = 0; s < 2; ++s) { const s16x8 pb = __builtin_bit_cast(s16x8, make_uint4(pw[4 * s], pw[4 * s + 1], pw[4 * s + 2], pw[4 * s + 3]));
#pragma unroll
        for (int dt = 0; dt < 4; ++dt) ot[dt] = MFMA16(ldfrag_perm(VT, 136, 16 * dt, 32 * s, lane), pb, ot[dt]); }
}
__device__ __forceinline__ void ph_nsa_t(const Params& p, unsigned char* smem, int tid, int lane, int wave, int item0, int istride) {
    NsaLds L;
    L.Ks = (bf16*)smem; L.VT = L.Ks + 128 * 72; L.Ps = L.VT + 64 * 136; L.PF = (float*)(L.Ps + 128 * 136); L.IMP = L.PF + 4 * 32 * 128; L.SELB = (unsigned char*)(L.IMP + 32 * 33);
    const bf16* PROJ = (const bf16*)(p.ws + O_PROJ); const bf16* QN = (const bf16*)(p.ws + O_QN);
    const bf16* KS = (const bf16*)(p.ws + O_KS); const bf16* KW = (const bf16*)(p.ws + O_KW);
    const bf16* KCMP = (const bf16*)(p.ws + O_KCMP); const bf16* VCMP = (const bf16*)(p.ws + O_VCMP);
    bf16* MIX = (bf16*)(p.ws + O_MIX);
    const int fr = lane & 15, fq = lane >> 4, hh = wave >> 1, qs = (wave & 1) * 16;
    for (int item = item0; item < BATCH * 64; item += istride) {
        const int qt = (item < 256) ? 63 - (item & 63) : (item & 63), b = item >> 6, blk = qt >> 1;
        const size_t rowb = (size_t)b * SEQ;
        const int tq = 32 * qt + qs + fr;
        s16x8 qf[2];
#pragma unroll
        for (int ks = 0; ks < 2; ++ks) qf[ks] = *(const s16x8*)(QN + (rowb + tq) * 256 + hh * 64 + 32 * ks + 8 * fq);
        const bf16* gp = PROJ + (rowb + tq) * INP + C_GATE + hh * 3;
        const float g0 = sigmoidf_(bf2f(gp[0])), g1 = sigmoidf_(bf2f(gp[1])), g2 = sigmoidf_(bf2f(gp[2]));
        f32x4v out[4];
        __syncthreads();
#pragma unroll
        for (int i = 0; i < 2; ++i) { const int idx = tid + NTHREADS * i, row = idx >> 3, c8 = idx & 7;
            const uint4 kv = *(const uint4*)(KCMP + ((size_t)b * 128 + row) * 64 + 8 * c8), vv = *(const uint4*)(VCMP + ((size_t)b * 128 + row) * 64 + 8 * c8);
            *(uint4*)(L.Ks + row * 72 + 8 * c8) = kv;
            const unsigned vw[4] = {vv.x, vv.y, vv.z, vv.w};
#pragma unroll
            for (int e = 0; e < 8; ++e) L.VT[(8 * c8 + e) * 136 + row] = (bf16)((e & 1) ? (vw[e >> 1] >> 16) : (vw[e >> 1] & 0xffffu)); }
        __syncthreads();
        {
            f32x4v st[8];
#pragma unroll
            for (int mt = 0; mt < 8; ++mt) { st[mt] = (f32x4v){0.f, 0.f, 0.f, 0.f};
#pragma unroll
                for (int ks = 0; ks < 2; ++ks) st[mt] = MFMA16(ldfrag(L.Ks, 72, 16 * mt, 32 * ks, lane), qf[ks], st[mt]); }
            float e[32]; float tm = -1e30f;
#pragma unroll
            for (int mt = 0; mt < 8; ++mt)
#pragma unroll
                for (int r = 0; r < 4; ++r) { e[4 * mt + r] = st[mt][r] * 0.125f; const bool vis = (16 * (16 * mt + 4 * fq + r) + 31 <= tq); tm = fmaxf(tm, vis ? e[4 * mt + r] : -1e30f); }
            tm = fmaxf(tm, __shfl_xor(tm, 16)); tm = fmaxf(tm, __shfl_xor(tm, 32));
            float ps = 0.f;
#pragma unroll
            for (int mt = 0; mt < 8; ++mt)
#pragma unroll
                for (int r = 0; r < 4; ++r) { const bool vis = (16 * (16 * mt + 4 * fq + r) + 31 <= tq); e[4 * mt + r] = vis ? fexp(e[4 * mt + r] - tm) : 0.f; ps += e[4 * mt + r]; }
            ps += __shfl_xor(ps, 16); ps += __shfl_xor(ps, 32);
            const float inv = (ps > 0.f) ? 1.f / ps : 0.f;
            unsigned pw[16];
#pragma unroll
            for (int mt = 0; mt < 8; ++mt) {
#pragma unroll
                for (int r = 0; r < 4; ++r) { e[4 * mt + r] *= inv; L.PF[(hh * 32 + qs + fr) * 128 + 16 * mt + 4 * fq + r] = e[4 * mt + r]; }
                pw[2 * mt] = pk2(e[4 * mt], e[4 * mt + 1]); pw[2 * mt + 1] = pk2(e[4 * mt + 2], e[4 * mt + 3]); }
            f32x4v oc[4];
#pragma unroll
            for (int dt = 0; dt < 4; ++dt) oc[dt] = (f32x4v){0.f, 0.f, 0.f, 0.f};
#pragma unroll
            for (int s = 0; s < 4; ++s) { const s16x8 pb = __builtin_bit_cast(s16x8, make_uint4(pw[4 * s], pw[4 * s + 1], pw[4 * s + 2], pw[4 * s + 3]));
#pragma unroll
                for (int dt = 0; dt < 4; ++dt) oc[dt] = MFMA16(ldfrag_perm(L.VT, 136, 16 * dt, 32 * s, lane), pb, oc[dt]); }
#pragma unroll
            for (int dt = 0; dt < 4; ++dt) out[dt] = oc[dt] * g0;
        }
        __syncthreads();
        if (blk >= 16) {
            const int q = tid >> 4, jj = tid & 15;
#pragma unroll
            for (int half = 0; half < 2; ++half) { const int j = jj + 16 * half;
                const int c0 = (4 * j - 1 < 0) ? 0 : 4 * j - 1, c1 = (4 * j + 3 > 126) ? 126 : 4 * j + 3;
                float a = 0.f;
                for (int c = c0; c <= c1; ++c) for (int h4 = 0; h4 < 4; ++h4) a += L.PF[(h4 * 32 + q) * 128 + c];
                L.IMP[q * 33 + j] = a; }
        }
        __syncthreads();
        {
            const int q = tid >> 4, jj = tid & 15;
#pragma unroll
            for (int half = 0; half < 2; ++half) { const int j = jj + 16 * half;
                bool sel;
                if (blk < 16) sel = (j <= blk);
                else if (j == 0 || j == blk || j == blk - 1) sel = true;
                else if (j > blk) sel = false;
                else { const float mine = L.IMP[q * 33 + j]; int rank = 0;
                    for (int j2 = 1; j2 <= blk - 2; ++j2) { const float ov = L.IMP[q * 33 + j2]; rank += (ov > mine || (ov == mine && j2 < j)) ? 1 : 0; }
                    sel = rank < 13; }
                L.SELB[q * 32 + j] = sel ? 1 : 0; }
        }
        {
            f32x4v o[4]; float m = -1e30f, lp = 0.f;
#pragma unroll
            for (int dt = 0; dt < 4; ++dt) o[dt] = (f32x4v){0.f, 0.f, 0.f, 0.f};
            uint4 nk, nv;
            nsa_load(nk, nv, KS + rowb * 64, 64, PROJ + rowb * INP + C_NKV + 192, INP, tid);
            __syncthreads();
            nsa_store(L.Ks, L.VT, nk, nv, tid);
            if (blk > 0) nsa_load(nk, nv, KS + (rowb + 64) * 64, 64, PROJ + (rowb + 64) * INP + C_NKV + 192, INP, tid);
            __syncthreads();
#pragma unroll 1
            for (int j = 0; j <= blk; ++j) {
                const bool odd = j & 1;
                bf16* Kc = odd ? L.Ps : L.Ks; bf16* Vc = odd ? (L.Ps + 64 * 72) : L.VT; bf16* Kn = odd ? L.Ks : L.Ps; bf16* Vn = odd ? L.VT : (L.Ps + 64 * 72);
                if (j < blk) { nsa_store(Kn, Vn, nk, nv, tid);
                    if (j + 1 < blk) nsa_load(nk, nv, KS + (rowb + 64 * (j + 2)) * 64, 64, PROJ + (rowb + 64 * (j + 2)) * INP + C_NKV + 192, INP, tid); }
                const bool sb = L.SELB[(qs + fr) * 32 + j] != 0;
                nsa_tile_t(Kc, Vc, qf, o, m, lp, lane, [&](int kk) { return sb && (64 * j + kk <= tq); });
                __syncthreads();
            }
            lp += __shfl_xor(lp, 16); lp += __shfl_xor(lp, 32);
            const float sc = g1 / lp;
#pragma unroll
            for (int dt = 0; dt < 4; ++dt) out[dt] = out[dt] + o[dt] * sc;
        }
        {
            f32x4v o[4]; float m = -1e30f, lp = 0.f;
#pragma unroll
            for (int dt = 0; dt < 4; ++dt) o[dt] = (f32x4v){0.f, 0.f, 0.f, 0.f};
            const int klo = (32 * qt - 511 < 0) ? 0 : ((32 * qt - 511) >> 6);
            uint4 nk, nv;
            nsa_load(nk, nv, KW + (rowb + 64 * klo) * 64, 64, PROJ + (rowb + 64 * klo) * INP + C_NKV + 320, INP, tid);
            nsa_store(L.Ks, L.VT, nk, nv, tid);
            if (klo < blk) nsa_load(nk, nv, KW + (rowb + 64 * (klo + 1)) * 64, 64, PROJ + (rowb + 64 * (klo + 1)) * INP + C_NKV + 320, INP, tid);
            __syncthreads();
#pragma unroll 1
            for (int j = klo; j <= blk; ++j) {
                const bool odd = (j - klo) & 1;
                bf16* Kc = odd ? L.Ps : L.Ks; bf16* Vc = odd ? (L.Ps + 64 * 72) : L.VT; bf16* Kn = odd ? L.Ks : L.Ps; bf16* Vn = odd ? L.VT : (L.Ps + 64 * 72);
                if (j < blk) { nsa_store(Kn, Vn, nk, nv, tid);
                    if (j + 1 < blk) nsa_load(nk, nv, KW + (rowb + 64 * (j + 2)) * 64, 64, PROJ + (rowb + 64 * (j + 2)) * INP + C_NKV + 320, INP, tid); }
                nsa_tile_t(Kc, Vc, qf, o, m, lp, lane, [&](int kk) { const int key = 64 * j + kk; return key <= tq && tq - key < 512; });
                __syncthreads();
            }
            lp += __shfl_xor(lp, 16); lp += __shfl_xor(lp, 32);
            const float sc = g2 / lp;
#pragma unroll
            for (int dt = 0; dt < 4; ++dt) out[dt] = out[dt] + o[dt] * sc;
        }
#pragma unroll
        for (int dt = 0; dt < 4; ++dt) *(uint2*)(MIX + (rowb + tq) * 1024 + 768 + hh * 64 + 16 * dt + 4 * fq) = make_uint2(pk2(out[dt][0], out[dt][1]), pk2(out[dt][2], out[dt][3]));
    }
}

__device__ __forceinline__ void ph_mixnorm(const Params& p, int l, int lane, int wave) {
    const int gw = blockIdx.x * 8 + wave, NGW = gridDim.x * 8;
    const bf16* MIX = (const bf16*)(p.ws + O_MIX); bf16* MIXN = (bf16*)(p.ws + O_MIXN);
    const int grp = (lane < 32) ? 0 : (lane < 48) ? 1 : 2;
    const float* w = (grp == 0) ? (p.ssd_norm_w + l * 512 + 16 * lane) : (grp == 1) ? (p.sb_out_w + l * 256 + 16 * (lane - 32)) : (p.nsa_out_w + l * 256 + 16 * (lane - 48));
    float wv[16];
#pragma unroll
    for (int i = 0; i < 16; ++i) wv[i] = w[i];
    for (int m = gw; m < T; m += NGW) {
        float v[16];
        const uint4* src = (const uint4*)(MIX + (size_t)m * 1024 + 16 * lane);
        unpack8(src[0], v); unpack8(src[1], v + 8);
        float ss = 0.f;
#pragma unroll
        for (int i = 0; i < 16; ++i) ss += v[i] * v[i];
        const float s0 = wave_sum(grp == 0 ? ss : 0.f), s1 = wave_sum(grp == 1 ? ss : 0.f), s2 = wave_sum(grp == 2 ? ss : 0.f);
        const float rstd = (grp == 0) ? rsqrtf(s0 * (1.f / 512.f) + EPS) : (grp == 1) ? rsqrtf(s1 * (1.f / 256.f) + EPS) : rsqrtf(s2 * (1.f / 256.f) + EPS);
        uint4 o[2]; unsigned* op = (unsigned*)o;
#pragma unroll
        for (int i = 0; i < 8; ++i) op[i] = pk2(v[2 * i] * rstd * wv[2 * i], v[2 * i + 1] * rstd * wv[2 * i + 1]);
        uint4* dst = (uint4*)(MIXN + (size_t)m * 1024 + 16 * lane);
        dst[0] = o[0]; dst[1] = o[1];
    }
}

__constant__ unsigned char CAND_I[50] = {0,0,0,0,0,0,0,0,0,0,0,0,0,0,0,0, 1,1,1,1,1,1,1,1, 2,2,2,2,2, 3,3,3,3, 4,4,4, 5,5, 6,6, 7,7, 8,9,10,11,12,13,14,15};
__constant__ unsigned char CAND_J[50] = {0,1,2,3,4,5,6,7,8,9,10,11,12,13,14,15, 0,1,2,3,4,5,6,7, 0,1,2,3,4, 0,1,2,3, 0,1,2, 0,1, 0,1, 0,1, 0,0,0,0,0,0,0,0};

__device__ __forceinline__ unsigned f2key(float v) { const unsigned u = __float_as_uint(v); return (u & 0x80000000u) ? ~u : (u | 0x80000000u); }
__device__ __forceinline__ float key2f(unsigned k) { const unsigned u = (k & 0x80000000u) ? (k ^ 0x80000000u) : ~k; return __uint_as_float(u); }
#define CE_DESC(a, b) do { const unsigned _hi = max((a), (b)), _lo = min((a), (b)); (a) = _hi; (b) = _lo; } while (0)
__device__ __forceinline__ void sort16_desc(unsigned (&v)[16]) {
#pragma unroll
    for (int k = 2; k <= 16; k <<= 1)
#pragma unroll
        for (int j = k >> 1; j > 0; j >>= 1)
#pragma unroll
            for (int i = 0; i < 16; ++i) { const int l = i ^ j; if (l > i) { if ((i & k) == 0) CE_DESC(v[i], v[l]); else CE_DESC(v[l], v[i]); } }
}
__device__ __forceinline__ void bitonic_merge16_desc(unsigned (&v)[16]) {
#pragma unroll
    for (int j = 8; j > 0; j >>= 1)
#pragma unroll
        for (int i = 0; i < 16; ++i) { const int l = i ^ j; if (l > i) CE_DESC(v[i], v[l]); }
}
__device__ __forceinline__ void merge_top16(unsigned (&a)[16], const unsigned (&b)[16]) {
#pragma unroll
    for (int i = 0; i < 16; ++i) a[i] = max(a[i], b[15 - i]);
    bitonic_merge16_desc(a);
}
template <int CTRL> __device__ __forceinline__ unsigned dpp_u(unsigned v) { return (unsigned)__builtin_amdgcn_update_dpp(0, (int)v, CTRL, 0xf, 0xf, true); }
template <int CTRL> __device__ __forceinline__ void merge_top16_lane(unsigned (&a)[16]) {
    unsigned t[16];
#pragma unroll
    for (int i = 0; i < 16; ++i) t[i] = max(a[i], dpp_u<CTRL>(a[15 - i]));
#pragma unroll
    for (int i = 0; i < 16; ++i) a[i] = t[i];
    bitonic_merge16_desc(a);
}

typedef __bf16 bf16x2_t __attribute__((ext_vector_type(2)));
__device__ __forceinline__ float dot2bf(unsigned a, unsigned b, float c) { return __builtin_amdgcn_fdot2_f32_bf16(__builtin_bit_cast(bf16x2_t, a), __builtin_bit_cast(bf16x2_t, b), c, false); }
__device__ __forceinline__ float gelu_erf(float v) {
    const float av = fabsf(v), t = __builtin_amdgcn_rcpf(av * 0.2316418882f + 1.0f);
    float q = t * 0.5307027145f + (-0.7265760135f); q = q * t + 0.7107068705f; q = q * t + (-0.142248368f); q = q * t + 0.127414796f; q = q * t;
    const float m = v * (q * __builtin_amdgcn_exp2f(v * v * (-0.72134752044f)));
    return v < 0.f ? m : v - m;
}
typedef float f32x2v __attribute__((ext_vector_type(2)));
__device__ __forceinline__ void ph_peer_fused(const Params& p, int l, const float* X1, float* XO, unsigned char* smem, int tid, int lane, int wave, const int tile) {
    float* SC = (float*)smem;
    unsigned* SK = (unsigned*)(SC + 128 * 129);
    int* EIL = (int*)smem;
    float* EGL = (float*)(EIL + 64 * 129);
    int* EIS = (int*)SK;
    float* EGS = (float*)(EIS + 64 * 128);
    const bf16* Q = (const bf16*)(p.ws + O_Q); const bf16* H2 = (const bf16*)(p.ws + O_H2);
    const bf16* KYB = (const bf16*)(p.ws + O_KYB) + (size_t)l * 2 * 128 * 128;
    const unsigned char* U8 = p.ws + O_UT + (size_t)l * 16384 * 1024; const unsigned char* V8 = p.ws + O_VT + (size_t)l * 16384 * 1024;
    const float* USC = (const float*)(p.ws + O_USC) + (size_t)l * 16384; const float* VSC = (const float*)(p.ws + O_VSC) + (size_t)l * 16384;
    const int fr = lane & 15, fq = lane >> 4, pp = wave >> 2, tw = 16 * (wave & 3), gi = lane >> 4, li = lane & 15;
    {
        const int t0 = tile * 64;
        __syncthreads();
        s16x8 kf[8][4];
#pragma unroll
        for (int nt = 0; nt < 8; ++nt)
#pragma unroll
            for (int ks = 0; ks < 4; ++ks) kf[nt][ks] = *(const s16x8*)(KYB + (size_t)(pp * 128 + 16 * nt + fr) * 128 + 32 * ks + 8 * fq);
        s16x8 qn0, qn1, qn2, qn3;
        { const bf16* qp = Q + (size_t)(t0 + tw + fr) * 2048 + pp * 128 + 8 * fq; qn0 = *(const s16x8*)qp; qn1 = *(const s16x8*)(qp + 32); qn2 = *(const s16x8*)(qp + 64); qn3 = *(const s16x8*)(qp + 96); }
#pragma unroll 1
        for (int h = 0; h < 8; ++h) {
            {
                const s16x8 qf[4] = {qn0, qn1, qn2, qn3};
                if (h < 7) { const bf16* qp = Q + (size_t)(t0 + tw + fr) * 2048 + (h + 1) * 256 + pp * 128 + 8 * fq; qn0 = *(const s16x8*)qp; qn1 = *(const s16x8*)(qp + 32); qn2 = *(const s16x8*)(qp + 64); qn3 = *(const s16x8*)(qp + 96); }
#pragma unroll
                for (int nt = 0; nt < 8; ++nt) { f32x4v s = {0.f, 0.f, 0.f, 0.f};
#pragma unroll
                    for (int ks = 0; ks < 4; ++ks) s = MFMA16(qf[ks], kf[nt][ks], s);
#pragma unroll
                    for (int r = 0; r < 4; ++r) SC[((tw + 4 * fq + r) * 2 + pp) * 129 + 16 * nt + fr] = s[r]; }
            }
            __syncthreads();
            {
                const int row = tid >> 2, qd = tid & 3;
                unsigned a[16], b[16];
#pragma unroll
                for (int i = 0; i < 16; ++i) { a[i] = (f2key(SC[row * 129 + 32 * qd + i]) & ~127u) | (unsigned)(127 - (32 * qd + i));
                                               b[i] = (f2key(SC[row * 129 + 32 * qd + 16 + i]) & ~127u) | (unsigned)(127 - (32 * qd + 16 + i)); }
                sort16_desc(a); sort16_desc(b); merge_top16(a, b);
                merge_top16_lane<0xB1>(a); merge_top16_lane<0x4E>(a);
#pragma unroll
                for (int i = 0; i < 16; ++i) if ((i >> 2) == qd) SK[(h * 128 + row) * 16 + i] = a[i];
            }
            __syncthreads();
        }
        {
            const int h = tid >> 6, tk = tid & 63;
                const unsigned* ka = SK + (h * 128 + 2 * tk) * 16; const unsigned* kb = ka + 16;
                float av[16], bv[16];
#pragma unroll
                for (int i = 0; i < 16; ++i) { av[i] = key2f(ka[i] & ~127u); bv[i] = key2f(kb[i] & ~127u); }
                unsigned c0[16], c1[16], c2[16], c3[16];
#define CKEY(C, I, J) ((f2key(av[I] + bv[J]) & ~63u) | (unsigned)(63 - (C)))
#pragma unroll
                for (int j = 0; j < 16; ++j) c0[j] = CKEY(j, 0, j);
#pragma unroll
                for (int j = 0; j < 8; ++j) c1[j] = CKEY(16 + j, 1, j);
#pragma unroll
                for (int j = 0; j < 5; ++j) c1[8 + j] = CKEY(24 + j, 2, j);
#pragma unroll
                for (int j = 0; j < 3; ++j) c1[13 + j] = CKEY(29 + j, 3, j);
                c2[0] = CKEY(32, 3, 3);
#pragma unroll
                for (int j = 0; j < 3; ++j) c2[1 + j] = CKEY(33 + j, 4, j);
#pragma unroll
                for (int j = 0; j < 2; ++j) { c2[4 + j] = CKEY(36 + j, 5, j); c2[6 + j] = CKEY(38 + j, 6, j); c2[8 + j] = CKEY(40 + j, 7, j); }
#pragma unroll
                for (int i = 0; i < 6; ++i) c2[10 + i] = CKEY(42 + i, 8 + i, 0);
                c3[0] = CKEY(48, 14, 0); c3[1] = CKEY(49, 15, 0);
#pragma unroll
                for (int i = 2; i < 16; ++i) c3[i] = 0u;
#undef CKEY
                sort16_desc(c0); sort16_desc(c1); sort16_desc(c2); sort16_desc(c3);
                merge_top16(c0, c1); merge_top16(c2, c3); merge_top16(c0, c2);
                const float mx = key2f(c0[0] & ~63u);
                float e[16], sum = 0.f; int ei[16];
#pragma unroll
                for (int r = 0; r < 16; ++r) { const int c = 63 - (int)(c0[r] & 63u);
                    e[r] = fexp(key2f(c0[r] & ~63u) - mx); sum += e[r];
                    const int ia = 127 - (int)(ka[CAND_I[c]] & 127u), ib = 127 - (int)(kb[CAND_J[c]] & 127u);
                    ei[r] = ia * 128 + ib; }
                const float inv = 1.f / sum;
#pragma unroll
                for (int r = 0; r < 16; ++r) { EIL[tk * 129 + h * 16 + r] = ei[r]; EGL[tk * 129 + h * 16 + r] = e[r] * inv; }
            }
        __syncthreads();
        {
            const int tk = tid >> 3, h = tid & 7;
            unsigned key[16], pos[16];
#pragma unroll
            for (int r = 0; r < 16; ++r) { key[r] = ((unsigned)(EIL[tk * 129 + h * 16 + r] >> 9) << 7) | (unsigned)(h * 16 + r); pos[r] = 0u; }
#pragma unroll 4
            for (int j = 0; j < 128; ++j) { const unsigned kj = ((unsigned)(EIL[tk * 129 + j] >> 9) << 7) | (unsigned)j;
#pragma unroll
                for (int r = 0; r < 16; ++r) pos[r] += (kj < key[r]) ? 1u : 0u; }
#pragma unroll
            for (int r = 0; r < 16; ++r) { EIS[tk * 128 + pos[r]] = EIL[tk * 129 + h * 16 + r]; EGS[tk * 128 + pos[r]] = EGL[tk * 129 + h * 16 + r]; }
        }
        __syncthreads();
#pragma unroll 1
        for (int tl = 8 * wave; tl < 8 * wave + 8; ++tl) {
            const int t = t0 + tl;
            float acc[64];
            uint4* xbl = (uint4*)(smem + wave * 2048);
            { const uint4* hs = (const uint4*)(H2 + (size_t)t * 1024); xbl[lane] = hs[lane]; xbl[lane + 64] = hs[lane + 64]; }
            LDS_FENCE();
            const uint2* xb2 = (const uint2*)xbl;
#pragma unroll
            for (int i = 0; i < 64; ++i) acc[i] = 0.f;
#define GF_LOAD(S, IT) do { const int ei_ = EIS[tl * 128 + 4 * (IT) + gi]; S##g = EGS[tl * 128 + 4 * (IT) + gi]; \
                const unsigned char* ur_ = U8 + (size_t)ei_ * 1024 + li * 16; const unsigned char* vr_ = V8 + (size_t)ei_ * 1024 + li * 16; \
                S##u0 = *(const uint4*)ur_; S##u1 = *(const uint4*)(ur_ + 256); S##u2 = *(const uint4*)(ur_ + 512); \
                S##v0 = *(const uint4*)vr_; S##v1 = *(const uint4*)(vr_ + 256); S##v2 = *(const uint4*)(vr_ + 512); S##us = USC[ei_]; S##vs = VSC[ei_]; } while (0)
#define GF_COMP(S) do { float d0 = 0.f, d1 = 0.f; \
                {   const v32f_t ua = __builtin_amdgcn_cvt_scalef32_pk32_f32_fp6((v6u_t){S##u0.x, S##u0.y, S##u0.z, S##u0.w, S##u1.x, S##u1.y}, 1.0f); \
                    _Pragma("unroll") for (int j = 0; j < 8; ++j) { const uint2 xq = xb2[2 * (16 * j + li)]; \
                        d0 += ua[4 * j] * __uint_as_float(xq.x << 16); d0 += ua[4 * j + 1] * __uint_as_float(xq.x & 0xffff0000u); d0 += ua[4 * j + 2] * __uint_as_float(xq.y << 16); d0 += ua[4 * j + 3] * __uint_as_float(xq.y & 0xffff0000u); } } \
                __builtin_amdgcn_sched_barrier(0); \
                {   const v32f_t ub = __builtin_amdgcn_cvt_scalef32_pk32_f32_fp6((v6u_t){S##u1.z, S##u1.w, S##u2.x, S##u2.y, S##u2.z, S##u2.w}, 1.0f); \
                    _Pragma("unroll") for (int j = 0; j < 8; ++j) { const uint2 xq = xb2[2 * (16 * j + li) + 1]; \
                        d1 += ub[4 * j] * __uint_as_float(xq.x << 16); d1 += ub[4 * j + 1] * __uint_as_float(xq.x & 0xffff0000u); d1 += ub[4 * j + 2] * __uint_as_float(xq.y << 16); d1 += ub[4 * j + 3] * __uint_as_float(xq.y & 0xffff0000u); } } \
                const float d = rowsum16(d0 + d1) * S##us; const float coef = S##g * gelu_erf(d) * S##vs; \
                __builtin_amdgcn_sched_barrier(0); \
                {   const v32f_t va = __builtin_amdgcn_cvt_scalef32_pk32_f32_fp6((v6u_t){S##v0.x, S##v0.y, S##v0.z, S##v0.w, S##v1.x, S##v1.y}, 1.0f); \
                    _Pragma("unroll") for (int j = 0; j < 32; ++j) acc[j] += coef * va[j]; } \
                __builtin_amdgcn_sched_barrier(0); \
                {   const v32f_t vb = __builtin_amdgcn_cvt_scalef32_pk32_f32_fp6((v6u_t){S##v1.z, S##v1.w, S##v2.x, S##v2.y, S##v2.z, S##v2.w}, 1.0f); \
                    _Pragma("unroll") for (int j = 0; j < 32; ++j) acc[32 + j] += coef * vb[j]; } } while (0)
            uint4 Au0, Au1, Au2, Av0, Av1, Av2, Bu0, Bu1, Bu2, Bv0, Bv1, Bv2; float Ag, Aus, Avs, Bg, Bus, Bvs;
            GF_LOAD(A, 0);
#pragma unroll 1
            for (int it = 0; it < 32; it += 2) {
                GF_LOAD(B, it + 1);
                GF_COMP(A);
                if (it + 2 < 32) GF_LOAD(A, it + 2);
                GF_COMP(B);
            }
#undef GF_LOAD
#undef GF_COMP
#pragma unroll
            for (int i = 0; i < 64; ++i) { acc[i] += __shfl_xor(acc[i], 16); acc[i] += __shfl_xor(acc[i], 32); }
            float o[16]; float ss = 0.f;
#pragma unroll
            for (int jj = 0; jj < 2; ++jj)
#pragma unroll
                for (int i = 0; i < 4; ++i) {
                    o[8 * jj + i]     = (gi == 0) ? acc[4 * jj + i]      : (gi == 1) ? acc[8 + 4 * jj + i]  : (gi == 2) ? acc[16 + 4 * jj + i] : acc[24 + 4 * jj + i];
                    o[8 * jj + 4 + i] = (gi == 0) ? acc[32 + 4 * jj + i] : (gi == 1) ? acc[40 + 4 * jj + i] : (gi == 2) ? acc[48 + 4 * jj + i] : acc[56 + 4 * jj + i]; }
            float4 xres[4];
#pragma unroll
            for (int q = 0; q < 4; ++q) xres[q] = *(const float4*)(X1 + (size_t)t * D + 128 * (2 * gi + (q >> 1)) + 8 * li + 4 * (q & 1));
#pragma unroll
            for (int q = 0; q < 4; ++q) { const size_t off = (size_t)t * D + 128 * (2 * gi + (q >> 1)) + 8 * li + 4 * (q & 1); const float4 x4 = xres[q];
                float4 r4 = {x4.x + o[4 * q], x4.y + o[4 * q + 1], x4.z + o[4 * q + 2], x4.w + o[4 * q + 3]};
                *(float4*)(XO + off) = r4; o[4 * q] = r4.x; o[4 * q + 1] = r4.y; o[4 * q + 2] = r4.z; o[4 * q + 3] = r4.w;
                ss += r4.x * r4.x + r4.y * r4.y + r4.z * r4.z + r4.w * r4.w; }
            if (l + 1 < NL) {
                const float rstd = rsqrtf(wave_sum(ss) * (1.f / D) + EPS);
#pragma unroll
                for (int jj = 0; jj < 2; ++jj) { const int col = 128 * (2 * gi + jj) + 8 * li;
                    const float4 w0 = *(const float4*)(p.norm1_w + (size_t)(l + 1) * D + col), w1 = *(const float4*)(p.norm1_w + (size_t)(l + 1) * D + col + 4);
                    uint4 ob; ob.x = pk2(o[8 * jj] * rstd * w0.x, o[8 * jj + 1] * rstd * w0.y); ob.y = pk2(o[8 * jj + 2] * rstd * w0.z, o[8 * jj + 3] * rstd * w0.w);
                    ob.z = pk2(o[8 * jj + 4] * rstd * w1.x, o[8 * jj + 5] * rstd * w1.y); ob.w = pk2(o[8 * jj + 6] * rstd * w1.z, o[8 * jj + 7] * rstd * w1.w);
                    *(uint4*)((bf16*)(p.ws + O_H1) + (size_t)t * D + col) = ob; }
            }
        }
    }
}

#define LAS __attribute__((address_space(3)))
#define XB_TMO      128
#define XB_XCNT(j)  (256  + 64 * (j))
#define XB_XSUB(j)  (1280 + 64 * (j))
#define XB_XGEN(j)  (2304 + 64 * (j))
#define XB_TOP      3328
#define XB_TOPGEN   3392
#define XCD_BAR_WORDS 3456
#define XB_SPIN_CAP (1u << 18)

__device__ __forceinline__ unsigned xb_ld(unsigned* p)              { return __hip_atomic_load(p, __ATOMIC_RELAXED, __HIP_MEMORY_SCOPE_AGENT); }
__device__ __forceinline__ unsigned xb_add(unsigned* p, unsigned v) { return __hip_atomic_fetch_add(p, v, __ATOMIC_RELAXED, __HIP_MEMORY_SCOPE_AGENT); }
__device__ __forceinline__ unsigned xb_xcc_id() { return (unsigned)__builtin_amdgcn_s_getreg((3 << 11) | 20) & 0xFu; }
#define XB_SPIN(cond, bar) do { unsigned _sp = 0; while (cond) { __builtin_amdgcn_s_sleep(1); \
    if ((++_sp & 255u) == 0u) { if (xb_ld(&(bar)[XB_TMO])) break; if (_sp > XB_SPIN_CAP) { atomicAdd(&(bar)[XB_TMO], 1u); break; } } } } while (0)

struct XcdBarrier {
    unsigned* bar; unsigned x;
    volatile LAS unsigned* st;
};

__device__ __forceinline__ XcdBarrier xcd_barrier_post(unsigned* bar, volatile LAS unsigned* st) {
    XcdBarrier b; b.bar = bar; b.x = xb_xcc_id(); b.st = st;
    if (threadIdx.x == 0) (void)xb_add(&bar[XB_XCNT(b.x)], 1u);
    return b;
}
__device__ __forceinline__ void xcd_barrier_complete(unsigned* bar, unsigned x, unsigned& nloc, unsigned& nx) {
    const unsigned G = gridDim.x * gridDim.y * gridDim.z;
    unsigned sum, cnt, mine, sp = 0u;
    for (;;) {
        sum = 0u; cnt = 0u; mine = 0u;
#pragma unroll
        for (unsigned j = 0; j < 16; ++j) { const unsigned c = xb_ld(&bar[XB_XCNT(j)]); sum += c; cnt += (c > 0u) ? 1u : 0u; mine = (j == x) ? c : mine; }
        if (sum == G) break;
        __builtin_amdgcn_s_sleep(1);
        if ((++sp & 255u) == 0u) { if (xb_ld(&bar[XB_TMO])) break; if (sp > XB_SPIN_CAP) { atomicAdd(&bar[XB_TMO], 1u); break; } }
    }
    nloc = mine > 0u ? mine : 1u; nx = cnt > 0u ? cnt : 1u;
}

__device__ __forceinline__ void xcd_barrier(const XcdBarrier& b, const int tid_in) {
    asm volatile("s_waitcnt vmcnt(0)" ::: "memory");
    __syncthreads();
    if (tid_in == 0) {
        unsigned* bar = b.bar;
        __builtin_amdgcn_s_waitcnt(0);
        unsigned nloc = b.st[0], nx = b.st[1];
        if (nloc == 0u) { xcd_barrier_complete(bar, b.x, nloc, nx); b.st[0] = nloc; b.st[1] = nx; }
        const unsigned old = xb_add(&bar[XB_XSUB(b.x)], 1u);
        const unsigned gen = old / nloc;
        if (old + 1u == (gen + 1u) * nloc) {
            __builtin_amdgcn_fence(__ATOMIC_RELEASE, "agent");
            asm volatile("s_waitcnt vmcnt(0)" ::: "memory");
            const unsigned og = xb_add(&bar[XB_TOP], 1u);
            const unsigned tg = og / nx;
            if (og + 1u == (tg + 1u) * nx) xb_add(&bar[XB_TOPGEN], 1u);
            else XB_SPIN(xb_ld(&bar[XB_TOPGEN]) == tg, bar);
            __builtin_amdgcn_fence(__ATOMIC_ACQUIRE, "agent");
            xb_add(&bar[XB_XGEN(b.x)], 1u);
            asm volatile("s_waitcnt vmcnt(0)" ::: "memory");
        } else {
            XB_SPIN(xb_ld(&bar[XB_XGEN(b.x)]) == gen, bar);
            __builtin_amdgcn_fence(__ATOMIC_ACQUIRE, "agent");
            asm volatile("s_waitcnt vmcnt(0)" ::: "memory");
        }
    }
    __syncthreads();
}

__device__ __forceinline__ Params load_params() {
#if defined(__HIP_DEVICE_COMPILE__)
    const __attribute__((address_space(4))) Params* kp = (const __attribute__((address_space(4))) Params*)__builtin_amdgcn_kernarg_segment_ptr();
    asm volatile("" : "+s"(kp));
    return *kp;
#else
    return Params{};
#endif
}
#define PH(stmt) do { const Params p = load_params(); MKTID; stmt; } while (0)
__global__ void __launch_bounds__(NTHREADS) mega(Params p_unused) {
    extern __shared__ __attribute__((aligned(16))) unsigned char smem[];
    float* lds = (float*)smem;
    cg::grid_group grid = cg::this_grid();
    const int tid0 = threadIdx.x;
    const int wave0 = __builtin_amdgcn_readfirstlane(tid0 >> 6);
    volatile LAS unsigned* misc = (volatile LAS unsigned*)((LAS unsigned char*)smem + (LDS_BYTES - 64));
    if (tid0 < 16) misc[tid0] = 0u;
    __syncthreads();
    { const Params p = load_params(); (void)xcd_barrier_post((unsigned*)(p.ws + O_CTL) + 1024, misc); }
#define GSYNC() do { const Params pb = load_params(); MKTID; XcdBarrier bb; bb.bar = (unsigned*)(pb.ws + O_CTL) + 1024; bb.x = xb_xcc_id(); \
        bb.st = (volatile LAS unsigned*)((LAS unsigned char*)smem + (LDS_BYTES - 64)); xcd_barrier(bb, tid); } while (0)

#define MKTID int zero_v = 0; asm volatile("" : "+v"(zero_v)); \
        const int lane = (int)__builtin_amdgcn_mbcnt_hi(~0u, __builtin_amdgcn_mbcnt_lo(~0u, (unsigned)zero_v)), wave = wave0, tid = wave * 64 + lane; (void)lane; (void)tid
    REP(1) if (SEL(1)) PH(ph_prep(p, lds, tid, lane, wave));
    grid.sync();
#pragma unroll 1
    for (int l = 0; l < NL; ++l) {
        REP(2) if (SEL(2)) {   const Params p = load_params(); MKTID;
            pg8::Gemm g{(const bf16*)(p.ws + O_H1), (const bf16*)(p.ws + O_WIN) + (size_t)l * INP * D, T, INP, D}; pg8::StaticOrder S; S.init(T, INP, gridDim.x, blockIdx.x);
            pg8::EpiBf16<0> E{(bf16*)(p.ws + O_PROJ), INP, nullptr, 0, 0, 1.f};
            pg8::gemm_phase<pg8::EpiBf16<0>, pg8::StaticOrder, true, true>((PG8_LAS unsigned char*)smem, g, S, E, tid); }
        GSYNC();
        REP(4) if (SEL(4)) { if (blockIdx.x >= 128) PH(ph_cmp_kv_fast(p, l, smem, tid, lane, wave, blockIdx.x - 128, gridDim.x - 128)); }
        REP(5) if (SEL(5)) PH(ph_ssd_p1(p, l, smem, tid, lane, wave, blockIdx.x, gridDim.x));
        REP(3) if (SEL(3)) PH(ph_elem(p, l, tid));
        GSYNC();
        REP(9) if (SEL(9)) PH(ph_ssd_scan(p, tid));
        GSYNC();
        REP(8) if (SEL(8)) PH(ph_ssd_p2(p, l, smem, tid, lane, wave, blockIdx.x, gridDim.x));
        REP(6) if (SEL(6)) PH(ph_sb_fast(p, smem, tid, lane, wave, blockIdx.x, gridDim.x));
        REP(7) if (SEL(7)) PH(ph_nsa_t(p, smem, tid, lane, wave, blockIdx.x, gridDim.x));
        GSYNC();
        REP(10) if (SEL(10)) PH(ph_mixnorm(p, l, lane, wave));
        GSYNC();
        REP(11) if (SEL(11)) {   const Params p = load_params(); MKTID; const float* xin = (l == 0) ? p.x : p.out; float* X1 = (float*)(p.ws + O_X1);
            pg8::Gemm g{(const bf16*)(p.ws + O_MIXN), (const bf16*)(p.ws + O_WOUT) + (size_t)l * D * D, T, D, D}; pg8::StaticOrder S; S.init(T, D, gridDim.x, blockIdx.x);
            pg8::EpiResF32 E{X1, xin, D};
            pg8::gemm_phase<pg8::EpiResF32, pg8::StaticOrder, true, true>((PG8_LAS unsigned char*)smem, g, S, E, tid); }
        GSYNC();
        {
            const Params p = load_params(); MKTID; const float* X1 = (const float*)(p.ws + O_X1);
            const int gw = blockIdx.x * 8 + wave, NGW = gridDim.x * 8;
            for (int m = gw; m < T; m += NGW) norm_row_to_bf16(X1 + (size_t)m * D, p.norm2_w + (size_t)l * D, (bf16*)(p.ws + O_H2) + (size_t)m * D, lane);
        }
        GSYNC();
        REP(12) if (SEL(12)) {   const Params p = load_params(); MKTID;
            pg8::Gemm g{(const bf16*)(p.ws + O_H2), (const bf16*)(p.ws + O_WQ) + (size_t)l * 2048 * D, T, 2048, D}; pg8::StaticOrder S; S.init(T, 2048, gridDim.x, blockIdx.x);
            pg8::EpiBf16<0> E{(bf16*)(p.ws + O_Q), 2048, nullptr, 0, 0, 1.f};
            pg8::gemm_phase<pg8::EpiBf16<0>, pg8::StaticOrder, true, true>((PG8_LAS unsigned char*)smem, g, S, E, tid); }
        GSYNC();
        REP(15) if (SEL(15)) {
#pragma unroll 1
            for (int tile = blockIdx.x; tile < T / 64; tile += gridDim.x) PH(ph_peer_fused(p, l, (const float*)(p.ws + O_X1), p.out, smem, tid, lane, wave, tile)); }
        if (l + 1 < NL) GSYNC();
    }
}

extern "C" void kernel_launch(void* const* d_in, const int* in_sizes, int n_in, void* d_out, int out_size, void* d_ws, size_t ws_size, hipStream_t stream) {
    static int grid = 0;
    if (grid == 0) {
        if (n_in != 21 || out_size != T * D || ws_size < WS_END) { fprintf(stderr, "kernel_launch: unexpected shapes (n_in %d out %d ws %zu)\n", n_in, out_size, ws_size); grid = -1; return; }
        int dev = 0, cus = 0, per_cu = 0;
        hipGetDevice(&dev);
        hipDeviceGetAttribute(&cus, hipDeviceAttributeMultiprocessorCount, dev);
        hipFuncSetAttribute((const void*)mega, hipFuncAttributeMaxDynamicSharedMemorySize, LDS_BYTES);
        hipOccupancyMaxActiveBlocksPerMultiprocessor(&per_cu, (const void*)mega, NTHREADS, LDS_BYTES);
        if (per_cu < 1) { fprintf(stderr, "kernel_launch: occupancy query says %d blocks/CU\n", per_cu); per_cu = 1; }
        grid = cus;
        (void)hipGetLastError();
    }
    if (grid < 0) return;
    if (hipMemsetAsync((char*)d_ws + O_CTL, 0, 65536, stream) != hipSuccess) { fprintf(stderr, "kernel_launch: memset of control words failed\n"); return; }
    Params p{};
    const float** pp = (const float**)&p;
    for (int i = 0; i < 21; ++i) pp[i] = (const float*)d_in[i];
    p.out = (float*)d_out; p.ws = (unsigned char*)d_ws;
    void* args[] = {&p};
    hipError_t e = hipLaunchCooperativeKernel((const void*)mega, dim3(grid), dim3(NTHREADS), args, LDS_BYTES, stream);
    if (e != hipSuccess) fprintf(stderr, "cooperative launch failed: %s (grid %d)\n", hipGetErrorString(e), grid);
}
```

```cpp
#include <hip/hip_runtime.h>
#include <hip/hip_cooperative_groups.h>
#include <cstdio>
#include <cstdint>
#include <type_traits>
namespace cg = cooperative_groups;

typedef unsigned short bf16;
constexpr int D = 1024, BATCH = 8, SEQ = 2048, T = BATCH * SEQ, NL = 2;
constexpr int IN_DIM = 2964, INP = 3072;
constexpr int C_Z = 0, C_XBC = 512, C_DT = 1536, C_SB = 1544, C_NQ = 2312, C_NKV = 2568, C_GATE = 2952;
constexpr int NTHREADS = 512;
constexpr int LDS_BYTES = 147456;
constexpr float EPS = 1e-6f;
#ifndef ONLY
#define ONLY 0
#endif
#define SEL(n) (ONLY == 0 || ONLY == (n))
#ifndef DUP
#define DUP 0
#endif
#define DUPHIT(n) (DUP == (n) || (DUP == 56 && ((n) == 5 || (n) == 6)) || (DUP == 34 && ((n) == 3 || (n) == 4)) || (DUP == 1012 && ((n) == 10 || (n) == 12)))
#define REP(n) for (int _rep = 0; _rep < (DUPHIT(n) ? 2 : 1); ++_rep)

constexpr size_t MiB = 1u << 20;
constexpr size_t O_CTL = 0, O_WIN = 1 * MiB, O_WOUT = 13 * MiB, O_WQ = 17 * MiB, O_UT = 25 * MiB, O_VT = 89 * MiB, O_H1 = 153 * MiB,
                 O_PROJ = 185 * MiB, O_XBC = 281 * MiB, O_MIX = 313 * MiB, O_X1 = 345 * MiB, O_QN = 409 * MiB, O_KS = 417 * MiB, O_KW = 419 * MiB,
                 O_KC = 421 * MiB, O_KCMP = 423 * MiB, O_VCMP = 423 * MiB + 512 * 1024, O_DT = 424 * MiB, O_SEL = 425 * MiB, O_TV = 426 * MiB,
                 O_TI = 442 * MiB, O_EI = 458 * MiB, O_EG = 466 * MiB, O_ROPE = 474 * MiB, O_WCT = 475 * MiB, O_OC = 476 * MiB, O_PS = 492 * MiB, WS_END = 493 * MiB;
constexpr size_t O_PBIAS = O_ROPE + 512 * 1024, O_USC = O_ROPE + 576 * 1024, O_VSC = O_ROPE + 704 * 1024, O_KYB = O_ROPE + 832 * 1024;
constexpr size_t O_SIN = O_OC;
constexpr size_t O_SLOC = O_TV, O_ATOT = O_EI;
constexpr size_t O_Q = O_PROJ, O_MIXN = O_XBC, O_H2 = O_MIX, O_PC = O_X1, O_NSAO = O_X1 + 32 * MiB;

struct Params {
    const float *x, *norm1_w, *w_in, *conv_w, *conv_b, *dt_bias, *a_log, *d_skip, *ssd_norm_w, *sb_out_w, *nsa_q_norm_w, *nsa_k_norm_w,
        *nsa_cmp_pos, *nsa_cmp_w, *nsa_out_w, *w_out, *norm2_w, *peer_w_q, *peer_sub_keys, *peer_u, *peer_v;
    float* out;
    unsigned char* ws;
};

__device__ __forceinline__ float bf2f(bf16 v) { return __uint_as_float(((unsigned)v) << 16); }
typedef __bf16 bf16pair_t __attribute__((ext_vector_type(2)));
typedef float f32pair_t __attribute__((ext_vector_type(2)));
template <int SEL> __device__ __forceinline__ unsigned pk_fp4(unsigned old, float a, float b) { return __builtin_amdgcn_cvt_scalef32_pk_fp4_f32(old, a, b, 1.0f, SEL); }
template <int SEL> __device__ __forceinline__ unsigned upb_fp4(unsigned w) { return __builtin_bit_cast(unsigned, __builtin_amdgcn_cvt_scalef32_pk_bf16_fp4(w, 1.0f, SEL)); }
template <int SEL> __device__ __forceinline__ f32pair_t up_fp4(unsigned w) { return __builtin_amdgcn_cvt_scalef32_pk_f32_fp4(w, 1.0f, SEL); }
__device__ __forceinline__ unsigned pk2(float lo, float hi) { const f32pair_t v = {lo, hi}; return __builtin_bit_cast(unsigned, __builtin_convertvector(v, bf16pair_t)); }
__device__ __forceinline__ bf16 f2bf(float f) { return (bf16)(pk2(f, 0.f) & 0xffffu); }
__device__ __forceinline__ float wave_sum(float v) {
#pragma unroll
    for (int o = 1; o < 64; o <<= 1) v += __shfl_xor(v, o);
    return v;
}
__device__ __forceinline__ void unpack8(uint4 u, float* f) {
    f[0] = __uint_as_float(u.x << 16); f[1] = __uint_as_float(u.x & 0xffff0000u);
    f[2] = __uint_as_float(u.y << 16); f[3] = __uint_as_float(u.y & 0xffff0000u);
    f[4] = __uint_as_float(u.z << 16); f[5] = __uint_as_float(u.z & 0xffff0000u);
    f[6] = __uint_as_float(u.w << 16); f[7] = __uint_as_float(u.w & 0xffff0000u);
}
__device__ __forceinline__ float fexp(float v) { return __builtin_amdgcn_exp2f(v * 1.44269504088896341f); }
__device__ __forceinline__ float frcp(float v) { return __builtin_amdgcn_rcpf(v); }
__device__ __forceinline__ float siluf(float v) { return v * frcp(1.f + fexp(-v)); }
__device__ __forceinline__ float sigmoidf_(float v) { return frcp(1.f + fexp(-v)); }
__device__ __forceinline__ float softplusf(float v) { return fmaxf(v, 0.f) + log1pf(expf(-fabsf(v))); }
__device__ __forceinline__ float softplus_fast(float v) { return fmaxf(v, 0.f) + 0.693147180559945f * __builtin_amdgcn_logf(1.f + fexp(-fabsf(v))); }

namespace pg8 {
#define PG8_LAS __attribute__((address_space(3)))
typedef unsigned short bf16_t;
typedef short bf16x8 __attribute__((ext_vector_type(8)));
typedef float f32x4 __attribute__((ext_vector_type(4)));
typedef unsigned u32x4 __attribute__((ext_vector_type(4)));
constexpr int BM = 256, BK = 64, HALF = 128, HTB = HALF * BK * 2  , STAGE_BYTES = 8 * HTB, NXCD = 8, WGM = 8;

__host__ __device__ __forceinline__ int lds_byte(int r, int c) { const int st = (r >> 4) * 2 + (c >> 5), rr = r & 15, cc = c & 31, ob = rr * 64 + cc * 2; return st * 1024 + (ob ^ (((ob >> 9) & 1) << 5)); }
__host__ __device__ __forceinline__ void stage_rc(int b, int& R, int& C) { const int st = b / 1024, sb = b % 1024, swz = sb ^ (((sb >> 9) & 1) << 5); R = (st >> 1) * 16 + swz / 64; C = (st & 1) * 32 + (swz % 64) / 2; }
__host__ __device__ __forceinline__ int perm32(int rho) { const int n = rho >> 4, i = rho & 15; return 8 * (i >> 2) + 4 * n + (i & 3); }

struct Unit { int pm, pn; };
struct Gemm { const bf16_t* A; const bf16_t* Bt; int M, N, K; };

struct StaticOrder {
    int nM, nN, nwg, G, c;
    __host__ __device__ void init(int M, int N, int G_, int c_) { nM = M / BM; nN = N / BM; nwg = nM * nN; G = G_; c = c_; }
    __host__ __device__ bool next(int i, Unit& u) const {
        const long L = (long)i * G + c; if (L >= nwg) return false;
        int wgid = (int)L; { const int q = nwg / NXCD, r = nwg % NXCD, xcd = wgid % NXCD, off = wgid / NXCD; wgid = (xcd < r ? xcd * (q + 1) : r * (q + 1) + (xcd - r) * q) + off; }
        const int nig = WGM * nN, gid = wgid / nig, fm = gid * WGM, gsz = (nM - fm) < WGM ? (nM - fm) : WGM;
        u.pm = fm + ((wgid % nig) % gsz); u.pn = (wgid % nig) / gsz; return true;
    }
    __device__ __forceinline__ void a_ready(const Unit&) const {}
    __device__ __forceinline__ void done(const Unit&) const {}
};

__device__ __forceinline__ unsigned cvt_pk_bf16(float lo, float hi) { unsigned r; asm volatile("v_cvt_pk_bf16_f32 %0, %1, %2" : "=v"(r) : "v"(lo), "v"(hi)); return r; }
typedef float f32x2 __attribute__((ext_vector_type(2)));
__device__ __forceinline__ f32x2 gelu_pk(f32x2 v) {
    const f32x2 av = __builtin_elementwise_abs(v), d = av * 0.2316418882f + 1.0f;
    f32x2 t; t.x = __builtin_amdgcn_rcpf(d.x); t.y = __builtin_amdgcn_rcpf(d.y);
    f32x2 q = t * 0.5307027145f + (-0.7265760135f); q = q * t + 0.7107068705f; q = q * t + (-0.142248368f); q = q * t + 0.127414796f; q = q * t;
    const f32x2 s = (v * v) * (-0.72134752044f);
    f32x2 e; e.x = __builtin_amdgcn_exp2f(s.x); e.y = __builtin_amdgcn_exp2f(s.y);
    const f32x2 m = v * (q * e), r = v - m;
    f32x2 o; o.x = v.x < 0.f ? m.x : r.x; o.y = v.y < 0.f ? m.y : r.y; return o;
}

template <int ACT  > struct EpiBf16 {
    static constexpr bool PERM = true, AFTER_DRAIN = false; static_assert(ACT == 0 || ACT == 1, "EpiBf16: ACT is 0 (none) or 1 (gelu_pk)");
    bf16_t* O; int ldc; const float* bias; int split_cols; size_t split_stride; float scale0;
    __device__ __forceinline__ void operator()(const f32x4 (&acc)[2][2][4][2], const Unit& u, int wr, int wc, int fr, int fq) const {
        const int row0 = u.pm * BM + wr * 64 + fr; int colt = u.pn * BM; bf16_t* base = O;
        float sc = 1.f; if (split_cols) { const int t = colt / split_cols; base += (size_t)t * split_stride; colt -= t * split_cols; if (t == 0) sc = scale0; }
        const int col0 = colt + wc * 32 + 8 * fq, bcol0 = u.pn * BM + wc * 32 + 8 * fq;
        f32x4 bv[2][2];
#pragma unroll
        for (int bj = 0; bj < 2; ++bj)
#pragma unroll
            for (int n = 0; n < 2; ++n) bv[bj][n] = bias ? *(const f32x4*)(bias + bcol0 + bj * HALF + 4 * n) : (f32x4){0.f, 0.f, 0.f, 0.f};
#pragma unroll
        for (int ai = 0; ai < 2; ++ai)
#pragma unroll
            for (int m = 0; m < 4; ++m) { bf16_t* rowp = base + (size_t)(row0 + ai * HALF + m * 16) * ldc + col0;
#pragma unroll
                for (int bj = 0; bj < 2; ++bj) { f32x4 v0 = acc[ai][bj][m][0] + bv[bj][0], v1 = acc[ai][bj][m][1] + bv[bj][1];
                    if (ACT == 1) { f32x2 a = gelu_pk((f32x2){v0[0], v0[1]}), b = gelu_pk((f32x2){v0[2], v0[3]}), c = gelu_pk((f32x2){v1[0], v1[1]}), d = gelu_pk((f32x2){v1[2], v1[3]});
                        v0 = (f32x4){a.x, a.y, b.x, b.y}; v1 = (f32x4){c.x, c.y, d.x, d.y}; }
                    v0 = v0 * sc; v1 = v1 * sc; u32x4 w; w.x = cvt_pk_bf16(v0[0], v0[1]); w.y = cvt_pk_bf16(v0[2], v0[3]); w.z = cvt_pk_bf16(v1[0], v1[1]); w.w = cvt_pk_bf16(v1[2], v1[3]);
                    *(u32x4*)(rowp + bj * HALF) = w; } }
    }
};

struct EpiResF32 {
    static constexpr bool PERM = true, AFTER_DRAIN = false;
    float* C; const float* R; int ldc; bf16_t* Cb; float* PS; const bf16_t* Rb;
    __device__ __forceinline__ void operator()(const f32x4 (&acc)[2][2][4][2], const Unit& u, int wr, int wc, int fr, int fq) const {
        const int row0 = u.pm * BM + wr * 64 + fr, col0 = u.pn * BM + wc * 32 + 8 * fq;
#pragma unroll
        for (int ai = 0; ai < 2; ++ai)
            {
                f32x4 rv[4][2][2];
                if (Rb) {
                    u32x4 rb[4][2];
#pragma unroll
                    for (int m = 0; m < 4; ++m) { const size_t off = (size_t)(row0 + ai * HALF + m * 16) * ldc + col0;
#pragma unroll
                        for (int bj = 0; bj < 2; ++bj) rb[m][bj] = *(const u32x4*)(Rb + off + bj * HALF); }
#pragma unroll
                    for (int m = 0; m < 4; ++m)
#pragma unroll
                        for (int bj = 0; bj < 2; ++bj) { const u32x4 q = rb[m][bj];
                            rv[m][bj][0] = (f32x4){__uint_as_float(q.x << 16), __uint_as_float(q.x & 0xffff0000u), __uint_as_float(q.y << 16), __uint_as_float(q.y & 0xffff0000u)};
                            rv[m][bj][1] = (f32x4){__uint_as_float(q.z << 16), __uint_as_float(q.z & 0xffff0000u), __uint_as_float(q.w << 16), __uint_as_float(q.w & 0xffff0000u)}; }
                } else {
#pragma unroll
                for (int m = 0; m < 4; ++m) { const size_t off = (size_t)(row0 + ai * HALF + m * 16) * ldc + col0;
#pragma unroll
                    for (int bj = 0; bj < 2; ++bj)
#pragma unroll
                        for (int n = 0; n < 2; ++n) rv[m][bj][n] = *(const f32x4*)(R + off + bj * HALF + n * 4); }
                }
#pragma unroll
                for (int m = 0; m < 4; ++m) { const size_t off = (size_t)(row0 + ai * HALF + m * 16) * ldc + col0; float ss = 0.f;
#pragma unroll
                    for (int bj = 0; bj < 2; ++bj) { const f32x4 v0 = acc[ai][bj][m][0] + rv[m][bj][0], v1 = acc[ai][bj][m][1] + rv[m][bj][1];
                        u32x4 w; w.x = cvt_pk_bf16(v0[0], v0[1]); w.y = cvt_pk_bf16(v0[2], v0[3]); w.z = cvt_pk_bf16(v1[0], v1[1]); w.w = cvt_pk_bf16(v1[2], v1[3]);
                        *(u32x4*)(Cb + off + bj * HALF) = w;
                        ss += v0[0] * v0[0] + v0[1] * v0[1] + v0[2] * v0[2] + v0[3] * v0[3] + v1[0] * v1[0] + v1[1] * v1[1] + v1[2] * v1[2] + v1[3] * v1[3]; }
                    ss += __shfl_xor(ss, 16); ss += __shfl_xor(ss, 32);
                    if (fq == 0) PS[(size_t)(row0 + ai * HALF + m * 16) * 16 + u.pn * 4 + wc] = ss; } }
    }
};

template <class Epi, class Sched, bool ALIGN_EPI = false, bool SP2 = false>
__device__ __forceinline__ void gemm_phase(PG8_LAS unsigned char* lds, const Gemm g, const Sched& S, const Epi& E, const int tid_in) {
    int tid_l = tid_in; asm volatile("" : "+v"(tid_l));
    const int tid = tid_l, wid = __builtin_amdgcn_readfirstlane(tid >> 6), lane = tid & 63, wr = wid >> 2, wc = wid & 3, fr = lane & 15, fq = lane >> 4;
    const int K = g.K, nt = K / BK;
    unsigned voffA[2], voffB[2];
#pragma unroll
    for (int i = 0; i < 2; ++i) { int R, C; stage_rc(tid * 16 + i * 8192, R, C); const int Rb = Epi::PERM ? ((R & ~31) + perm32(R & 31)) : R;
        voffA[i] = (unsigned)(R * K + C) * 2u; voffB[i] = (unsigned)(Rb * K + C) * 2u; }
    const size_t kstep = (size_t)(BK * 2);
    const size_t hstep = (size_t)HALF * K * 2;
    const size_t tstep = 2 * hstep;
    const unsigned ldsw = (unsigned)wid * 1024u;
    const int aoff = lds_byte(wr * 64 + fr, fq * 8), boff = lds_byte(wc * 32 + fr, fq * 8);
#define PG8_SA(b, h) (((b) * 2 + (h)) * HTB)
#define PG8_SB(b, h) ((4 + (b) * 2 + (h)) * HTB)
#define PG8_STAGE(bufoff, gbase, voff) do { _Pragma("unroll") for (int _i = 0; _i < 2; ++_i) \
        __builtin_amdgcn_global_load_lds((const unsigned*)((const char*)(gbase) + (voff)[_i]), (PG8_LAS unsigned*)(lds + (bufoff) + ldsw + _i * 8192), 16, 0, 0); } while (0)
#define PG8_LDA(dst, b, h) do { _Pragma("unroll") for (int m = 0; m < 4; ++m) _Pragma("unroll") for (int k = 0; k < 2; ++k) dst[m][k] = *(const PG8_LAS bf16x8*)(lds + PG8_SA(b, h) + aoff + m * 2048 + k * 1024); } while (0)
#define PG8_LDB(dst, b, h) do { _Pragma("unroll") for (int n = 0; n < 2; ++n) _Pragma("unroll") for (int k = 0; k < 2; ++k) dst[n][k] = *(const PG8_LAS bf16x8*)(lds + PG8_SB(b, h) + boff + n * 2048 + k * 1024); } while (0)
#define PG8_MMA(ai, bj, At, Bt) do { __builtin_amdgcn_s_setprio(1); _Pragma("unroll") for (int m = 0; m < 4; ++m) _Pragma("unroll") for (int n = 0; n < 2; ++n) _Pragma("unroll") for (int k = 0; k < 2; ++k) \
        acc[ai][bj][m][n] = __builtin_amdgcn_mfma_f32_16x16x32_bf16(Bt[n][k], At[m][k], acc[ai][bj][m][n], 0, 0, 0); __builtin_amdgcn_s_setprio(0); } while (0)
#define PG8_WAIT_V(n) asm volatile("s_waitcnt vmcnt(" #n ")" ::: "memory")
#define PG8_WAIT_L(n) asm volatile("s_waitcnt lgkmcnt(" #n ")" ::: "memory")
#define PG8_BAR __builtin_amdgcn_s_barrier()
#define PG8_SCHED __builtin_amdgcn_sched_barrier(0)
    Unit cur, nxt; int ui = 0;
    if (!S.next(0, cur)) return;
    f32x4 acc[2][2][4][2];
#pragma unroll
    for (int a = 0; a < 2; ++a)
#pragma unroll
        for (int b = 0; b < 2; ++b)
#pragma unroll
            for (int m = 0; m < 4; ++m)
#pragma unroll
                for (int n = 0; n < 2; ++n) acc[a][b][m][n] = (f32x4){0.f, 0.f, 0.f, 0.f};
    bf16x8 At[4][2], B0[2][2], B1[2][2];
    const char* cA = (const char*)g.A + (size_t)cur.pm * tstep; const char* cB = (const char*)g.Bt + (size_t)cur.pn * tstep;
    S.a_ready(cur);
    if constexpr (SP2) {
        PG8_STAGE(PG8_SB(0, 0), cB, voffB); PG8_STAGE(PG8_SB(0, 1), cB + hstep, voffB); PG8_STAGE(PG8_SA(0, 0), cA, voffA); PG8_STAGE(PG8_SA(0, 1), cA + hstep, voffA);
        if (wr == 1) PG8_BAR;
        PG8_WAIT_V(2); PG8_BAR;
        PG8_STAGE(PG8_SB(1, 0), cB + kstep, voffB); PG8_STAGE(PG8_SA(1, 0), cA + kstep, voffA); PG8_STAGE(PG8_SB(1, 1), cB + hstep + kstep, voffB);
        PG8_WAIT_V(6); PG8_BAR;
    } else {
        PG8_STAGE(PG8_SB(0, 0), cB, voffB); PG8_STAGE(PG8_SA(0, 0), cA, voffA); PG8_STAGE(PG8_SB(0, 1), cB + hstep, voffB); PG8_STAGE(PG8_SA(0, 1), cA + hstep, voffA);
        if (wr == 1) PG8_BAR;
        PG8_WAIT_V(4); PG8_BAR;
        PG8_STAGE(PG8_SB(1, 0), cB + kstep, voffB); PG8_STAGE(PG8_SA(1, 0), cA + kstep, voffA); PG8_STAGE(PG8_SB(1, 1), cB + hstep + kstep, voffB);
        PG8_WAIT_V(6); PG8_BAR;
    }
    for (;;) {
        const bool has_next = S.next(ui + 1, nxt);
        const char* nA = has_next ? (const char*)g.A + (size_t)nxt.pm * tstep : cA; const char* nB = has_next ? (const char*)g.Bt + (size_t)nxt.pn * tstep : cB;
        for (int t = 0; t < nt; t += 2) {
            const bool last = (t == nt - 2);
            const char* a1 = cA + (size_t)(t + 1) * kstep;
            const char* a2 = last ? nA : cA + (size_t)(t + 2) * kstep; const char* b2 = last ? nB : cB + (size_t)(t + 2) * kstep;
            const char* a3 = a2 + kstep; const char* b3 = b2 + kstep;
            if (last && has_next) S.a_ready(nxt);
            if constexpr (SP2) {
            PG8_LDB(B0, 0, 0); PG8_LDB(B1, 0, 1); PG8_SCHED; PG8_LDA(At, 0, 0); PG8_STAGE(PG8_SA(1, 1), a1 + hstep, voffA);
            PG8_WAIT_V(8); PG8_WAIT_L(0); PG8_BAR; PG8_MMA(0, 0, At, B0); PG8_MMA(0, 1, At, B1); PG8_BAR; PG8_SCHED;
            PG8_LDA(At, 0, 1); PG8_STAGE(PG8_SB(0, 0), b2, voffB); PG8_STAGE(PG8_SB(0, 1), b2 + hstep, voffB); PG8_STAGE(PG8_SA(0, 0), a2, voffA);
            PG8_WAIT_V(8); PG8_WAIT_L(0); PG8_BAR; PG8_MMA(1, 0, At, B0); PG8_MMA(1, 1, At, B1); PG8_BAR; PG8_SCHED;
            PG8_LDB(B0, 1, 0); PG8_LDB(B1, 1, 1); PG8_SCHED; PG8_LDA(At, 1, 0); PG8_STAGE(PG8_SA(0, 1), a2 + hstep, voffA);
            PG8_WAIT_V(8); PG8_WAIT_L(0); PG8_BAR; PG8_MMA(0, 0, At, B0); PG8_MMA(0, 1, At, B1); PG8_BAR; PG8_SCHED;
            PG8_LDA(At, 1, 1); PG8_STAGE(PG8_SB(1, 0), b3, voffB); PG8_STAGE(PG8_SB(1, 1), b3 + hstep, voffB); PG8_STAGE(PG8_SA(1, 0), a3, voffA);
            PG8_WAIT_V(8); PG8_WAIT_L(0); PG8_BAR; PG8_MMA(1, 0, At, B0); PG8_MMA(1, 1, At, B1); PG8_BAR; PG8_SCHED;
            } else {
            PG8_LDB(B0, 0, 0); PG8_SCHED; PG8_LDA(At, 0, 0); PG8_STAGE(PG8_SA(1, 1), a1 + hstep, voffA);
            PG8_WAIT_L(8); PG8_BAR; PG8_WAIT_L(0); PG8_MMA(0, 0, At, B0); PG8_BAR; PG8_SCHED;
            PG8_LDB(B1, 0, 1); PG8_STAGE(PG8_SB(0, 0), b2, voffB);
            PG8_BAR; PG8_WAIT_L(0); PG8_MMA(0, 1, At, B1); PG8_BAR;
            PG8_LDA(At, 0, 1); PG8_STAGE(PG8_SA(0, 0), a2, voffA);
            PG8_BAR; PG8_WAIT_L(0); PG8_MMA(1, 0, At, B0); PG8_BAR; PG8_SCHED;
            PG8_STAGE(PG8_SB(0, 1), b2 + hstep, voffB);
            PG8_WAIT_V(6); PG8_BAR; PG8_MMA(1, 1, At, B1); PG8_BAR;
            PG8_LDB(B0, 1, 0); PG8_SCHED; PG8_LDA(At, 1, 0); PG8_STAGE(PG8_SA(0, 1), a2 + hstep, voffA);
            PG8_WAIT_L(8); PG8_BAR; PG8_WAIT_L(0); PG8_MMA(0, 0, At, B0); PG8_BAR; PG8_SCHED;
            PG8_LDB(B1, 1, 1); PG8_STAGE(PG8_SB(1, 0), b3, voffB);
            PG8_BAR; PG8_WAIT_L(0); PG8_MMA(0, 1, At, B1); PG8_BAR;
            PG8_LDA(At, 1, 1); PG8_STAGE(PG8_SA(1, 0), a3, voffA);
            PG8_BAR; PG8_WAIT_L(0); PG8_MMA(1, 0, At, B0); PG8_BAR; PG8_SCHED;
            PG8_STAGE(PG8_SB(1, 1), b3 + hstep, voffB);
            PG8_WAIT_V(6); PG8_BAR; PG8_MMA(1, 1, At, B1); PG8_BAR;
            }
        }
        if constexpr (ALIGN_EPI) { if (wr == 0) PG8_BAR; }
        if constexpr (!Epi::AFTER_DRAIN) { E(acc, cur, wr, wc, fr, fq); S.done(cur); }
        if (!has_next) break;
#pragma unroll
        for (int a = 0; a < 2; ++a)
#pragma unroll
            for (int b = 0; b < 2; ++b)
#pragma unroll
                for (int m = 0; m < 4; ++m)
#pragma unroll
                    for (int n = 0; n < 2; ++n) acc[a][b][m][n] = (f32x4){0.f, 0.f, 0.f, 0.f};
        cur = nxt; cA = nA; cB = nB; ++ui;
        if constexpr (ALIGN_EPI) { if (wr == 1) PG8_BAR; }
    }
    PG8_WAIT_V(0);
    if constexpr (!ALIGN_EPI) { if (wr == 0) PG8_BAR; }
    PG8_BAR;
    if constexpr (Epi::AFTER_DRAIN) { E.fused(acc, cur, wr, wc, fr, fq, lds, wid, lane); S.done(cur); }
#undef PG8_SA
#undef PG8_SB
#undef PG8_STAGE
#undef PG8_LDA
#undef PG8_LDB
#undef PG8_MMA
#undef PG8_WAIT_V
#undef PG8_WAIT_L
#undef PG8_BAR
#undef PG8_SCHED
}
}

typedef float v16f_t __attribute__((ext_vector_type(16)));
typedef float v32f_t __attribute__((ext_vector_type(32)));
typedef unsigned v6u_t __attribute__((ext_vector_type(6)));
typedef unsigned v16u_t __attribute__((ext_vector_type(16)));

__device__ __forceinline__ void transpose_item(const float* W, int K, int Nsrc, bf16* WT, float* scr, int kb, int nb, int lane, const float* ksc = nullptr) {
    const int k0 = 64 * kb, n0 = 32 * nb;
    const int n = n0 + (lane & 31); const bool inb = n < Nsrc;
    const float* src = W + (size_t)(k0 + (lane >> 5)) * Nsrc + (inb ? n : Nsrc - 1);
    const int c = lane & 7;
    float q[8];
    if (ksc) { const float4 a = *(const float4*)(ksc + k0 + 8 * c), b = *(const float4*)(ksc + k0 + 8 * c + 4); q[0] = a.x; q[1] = a.y; q[2] = a.z; q[3] = a.w; q[4] = b.x; q[5] = b.y; q[6] = b.z; q[7] = b.w; }
    else {
#pragma unroll
        for (int j = 0; j < 8; ++j) q[j] = 1.f; }
    float v[32];
#pragma unroll
    for (int i = 0; i < 32; ++i) v[i] = src[(size_t)(2 * i) * Nsrc];
#pragma unroll
    for (int i = 0; i < 32; ++i) scr[(2 * i + (lane >> 5)) * 33 + (lane & 31)] = inb ? v[i] : 0.f;
    asm volatile("s_waitcnt lgkmcnt(0)" ::: "memory");
#pragma unroll
    for (int j = 0; j < 4; ++j) {
        const int nl = (lane >> 3) + 8 * j;
        const float* s = scr + (8 * c) * 33 + nl;
        uint4 o;
        o.x = pk2(s[0 * 33] * q[0], s[1 * 33] * q[1]); o.y = pk2(s[2 * 33] * q[2], s[3 * 33] * q[3]); o.z = pk2(s[4 * 33] * q[4], s[5 * 33] * q[5]); o.w = pk2(s[6 * 33] * q[6], s[7 * 33] * q[7]);
        *(uint4*)(WT + (size_t)(n0 + nl) * K + k0 + 8 * c) = o;
    }
    asm volatile("s_waitcnt lgkmcnt(0)" ::: "memory");
}

__device__ __forceinline__ void norm_row_to_bf16(const float* xrow, const float* w, bf16* orow, int lane) {
    float v[16];
    const float4* xr = (const float4*)(xrow + 16 * lane);
    float ss = 0.f;
#pragma unroll
    for (int j = 0; j < 4; ++j) { float4 a = xr[j]; v[4 * j] = a.x; v[4 * j + 1] = a.y; v[4 * j + 2] = a.z; v[4 * j + 3] = a.w; ss += a.x * a.x + a.y * a.y + a.z * a.z + a.w * a.w; }
    const float rstd = rsqrtf(wave_sum(ss) * (1.f / D) + EPS);
    const float4* wr = (const float4*)(w + 16 * lane);
    uint4 o[2];
    unsigned* op = (unsigned*)o;
#pragma unroll
    for (int j = 0; j < 4; ++j) { float4 ww = wr[j]; op[2 * j] = pk2(v[4 * j] * rstd * ww.x, v[4 * j + 1] * rstd * ww.y); op[2 * j + 1] = pk2(v[4 * j + 2] * rstd * ww.z, v[4 * j + 3] * rstd * ww.w); }
    uint4* od = (uint4*)(orow + 16 * lane);
    od[0] = o[0]; od[1] = o[1];
}

__device__ __forceinline__ void ph_prep(const Params& p, float* lds, int tid, int lane, int wave) {
    float* scr = lds + wave * (64 * 33);
    const int gw = blockIdx.x * 8 + wave, NGW = gridDim.x * 8;
    const int gtid = blockIdx.x * NTHREADS + tid, GS = gridDim.x * NTHREADS;
    constexpr int I_IN = 16 * 96, I_OUT = 16 * 32, I_Q = 16 * 64, I_ALL = NL * (I_IN + I_OUT + I_Q);
    for (int it = gw; it < I_ALL; it += NGW) {
        int r = it; const int l = r / (I_IN + I_OUT + I_Q); r -= l * (I_IN + I_OUT + I_Q);
        if (r < I_IN) { transpose_item(p.w_in + (size_t)l * D * IN_DIM, D, IN_DIM, (bf16*)(p.ws + O_WIN) + (size_t)l * INP * D, scr, r / 96, r % 96, lane); continue; }
        r -= I_IN;
        if (r < I_OUT) { transpose_item(p.w_out + (size_t)l * D * D, D, D, (bf16*)(p.ws + O_WOUT) + (size_t)l * D * D, scr, r / 32, r % 32, lane); continue; }
        r -= I_OUT;
        transpose_item(p.peer_w_q + (size_t)l * D * 2048, D, 2048, (bf16*)(p.ws + O_WQ) + (size_t)l * 2048 * D, scr, r / 64, r % 64, lane, p.norm2_w + (size_t)l * D);
    }
    for (int i = gtid; i < NL * 2 * 64 * 4 * 64; i += GS) {
        const int ln = i & 63, nt = (i >> 6) & 3, ksg = (i >> 8) & 63, tb = i >> 14;
        const float* W = p.nsa_cmp_w + (size_t)tb * 2048 * 64 + (size_t)(32 * ksg + 8 * (ln >> 4)) * 64 + 16 * nt + (ln & 15);
        uint4 o; o.x = pk2(W[0], W[64]); o.y = pk2(W[128], W[192]); o.z = pk2(W[256], W[320]); o.w = pk2(W[384], W[448]);
        ((uint4*)(p.ws + O_WCT))[i] = o;
    }
    for (int it = gw; it < NL * 2 * 64; it += NGW) {
        const int tb = it >> 6, n = it & 63; const float* W = p.nsa_cmp_w + (size_t)tb * 2048 * 64; const float* ps = p.nsa_cmp_pos + (size_t)tb * 2048;
        float a = 0.f;
#pragma unroll 8
        for (int j = 0; j < 32; ++j) a += ps[lane + 64 * j] * W[(size_t)(lane + 64 * j) * 64 + n];
        a = wave_sum(a);
        if (lane == 0) ((float*)(p.ws + O_PBIAS))[it] = a; }
    for (int rp = gw * 2; rp < NL * 16384 / 2; rp += NGW * 2) {
        v16f_t x[2][2][2];
#pragma unroll
        for (int tb = 0; tb < 2; ++tb)
#pragma unroll
            for (int q = 0; q < 2; ++q) { const int row = 2 * (rp + q) + (lane >> 5);
                const pg8::f32x4* srow = (const pg8::f32x4*)((tb ? p.peer_v : p.peer_u) + (size_t)row * 1024 + 4 * (lane & 31));
#pragma unroll
                for (int j = 0; j < 8; ++j) { const pg8::f32x4 a = __builtin_nontemporal_load(srow + 32 * j);
                    x[tb][q][0][2 * j] = a[0]; x[tb][q][1][2 * j] = a[1]; x[tb][q][0][2 * j + 1] = a[2]; x[tb][q][1][2 * j + 1] = a[3]; } }
#pragma unroll
        for (int tb = 0; tb < 2; ++tb)
#pragma unroll
            for (int q = 0; q < 2; ++q) { const int row = 2 * (rp + q) + (lane >> 5);
                float am = 0.f;
#pragma unroll
                for (int j = 0; j < 16; ++j) am = fmaxf(am, fmaxf(fabsf(x[tb][q][0][j]), fabsf(x[tb][q][1][j])));
#pragma unroll
                for (int o = 1; o < 32; o <<= 1) am = fmaxf(am, __shfl_xor(am, o));
                {
                    const float sc4 = (am > 0.f) ? 6.0f / am : 0.f;
                    unsigned wd[4] = {0u, 0u, 0u, 0u};
#define C6(v) fminf(fmaxf((v) * sc4, -6.0f), 6.0f)
#pragma unroll
                    for (int w = 0; w < 4; ++w) { unsigned d = 0u;
                        d = pk_fp4<0>(d, C6(x[tb][q][0][4 * w]), C6(x[tb][q][1][4 * w])); d = pk_fp4<1>(d, C6(x[tb][q][0][4 * w + 1]), C6(x[tb][q][1][4 * w + 1]));
                        d = pk_fp4<2>(d, C6(x[tb][q][0][4 * w + 2]), C6(x[tb][q][1][4 * w + 2])); d = pk_fp4<3>(d, C6(x[tb][q][0][4 * w + 3]), C6(x[tb][q][1][4 * w + 3])); wd[w] = d; }
#undef C6
                    unsigned char* rowp4 = p.ws + O_UT + (size_t)row * 1024 + (tb ? 512 : 0); const int q32 = lane & 31;
                    *(uint4*)(rowp4 + (q32 & 1) * 256 + (q32 >> 1) * 16) = make_uint4(wd[0], wd[1], wd[2], wd[3]);
                    if (q32 == 0) ((float*)(p.ws + (tb ? O_VSC : O_USC)))[row] = am * (1.f / 6.0f); } }
    }
    for (int i = gtid; i < NL * 2 * 128 * 128 / 8; i += GS) { const float4 a = ((const float4*)p.peer_sub_keys)[2 * i], b4 = ((const float4*)p.peer_sub_keys)[2 * i + 1];
        uint4 o; o.x = pk2(a.x, a.y); o.y = pk2(a.z, a.w); o.z = pk2(b4.x, b4.y); o.w = pk2(b4.z, b4.w); ((uint4*)(p.ws + O_KYB))[i] = o; }
    {
        float* rc = (float*)(p.ws + O_ROPE); float* rs = rc + SEQ * 8;
        if (wave == 0) for (int i = blockIdx.x * 64 + lane; i < SEQ * 8; i += gridDim.x * 64) {
            const int pos = i >> 3, k = i & 7;
            const float invf = (k == 0) ? 1.0f : (k == 1) ? 1.9392274e-01f : (k == 2) ? 3.7606031e-02f : (k == 3) ? 7.2926646e-03f : (k == 4) ? 1.4142136e-03f : (k == 5) ? 2.7424819e-04f : (k == 6) ? 5.3182961e-05f : 1.0313386e-05f;
            const float ang = (float)pos * invf;
            rc[i] = cosf(ang); rs[i] = sinf(ang);
        }
    }
    for (int m = gw; m < T; m += NGW) norm_row_to_bf16(p.x + (size_t)m * D, p.norm1_w, (bf16*)(p.ws + O_H1) + (size_t)m * D, lane);
}

typedef short s16x8 __attribute__((ext_vector_type(8)));
typedef float f32x4v __attribute__((ext_vector_type(4)));
#define MFMA16(a, b, c) __builtin_amdgcn_mfma_f32_16x16x32_bf16((a), (b), (c), 0, 0, 0)
__device__ __forceinline__ s16x8 ldfrag(const bf16* base, int stride, int row0, int k0, int lane) {
    return *(const s16x8*)(base + (row0 + (lane & 15)) * stride + k0 + 8 * (lane >> 4));
}
__device__ __forceinline__ int vt_swz(int c8) { return ((c8 & 3) << 2) | ((c8 >> 2) << 5); }
__device__ __forceinline__ s16x8 ldfrag_sw8(const bf16* base, int stride, int row0, int k0, int lane) {
    const int row = row0 + (lane & 15);
    return *(const s16x8*)(base + row * stride + ((k0 + 8 * (lane >> 4)) ^ (((row >> 3) & 7) << 3)));
}
__device__ __forceinline__ s16x8 ldfrag_perm(const bf16* base, int stride, int row0, int k0, int lane) {
    const int row = row0 + (lane & 15), sw = vt_swz(row >> 3);
    const bf16* p = base + row * stride + (k0 ^ (sw & 32)) + ((4 * (lane >> 4)) ^ (sw & 12));
    const uint2 a = *(const uint2*)p, b = *(const uint2*)(p + 16);
    return __builtin_bit_cast(s16x8, make_uint4(a.x, a.y, b.x, b.y));
}
template <int CTRL> __device__ __forceinline__ float dpp_f(float v) { return __builtin_bit_cast(float, __builtin_amdgcn_update_dpp(0, __builtin_bit_cast(int, v), CTRL, 0xf, 0xf, true)); }
__device__ __forceinline__ float suffix16(float v) { v += dpp_f<0x101>(v); v += dpp_f<0x102>(v); v += dpp_f<0x104>(v); v += dpp_f<0x108>(v); return v; }
__device__ __forceinline__ float rowsum16(float v) { v += dpp_f<0x128>(v); v += dpp_f<0x124>(v); v += dpp_f<0x122>(v); v += dpp_f<0x121>(v); return v; }
__device__ __forceinline__ float rowmax16(float v) { v = fmaxf(v, dpp_f<0x128>(v)); v = fmaxf(v, dpp_f<0x124>(v)); v = fmaxf(v, dpp_f<0x122>(v)); v = fmaxf(v, dpp_f<0x121>(v)); return v; }
__device__ __forceinline__ float xsum16(float v) { const unsigned u = __float_as_uint(v); const auto r = __builtin_amdgcn_permlane16_swap(u, u, false, false); return __uint_as_float(r[0]) + __uint_as_float(r[1]); }
__device__ __forceinline__ float xsum32(float v) { const unsigned u = __float_as_uint(v); const auto r = __builtin_amdgcn_permlane32_swap(u, u, false, false); return __uint_as_float(r[0]) + __uint_as_float(r[1]); }
__device__ __forceinline__ float xmax16(float v) { const unsigned u = __float_as_uint(v); const auto r = __builtin_amdgcn_permlane16_swap(u, u, false, false); return fmaxf(__uint_as_float(r[0]), __uint_as_float(r[1])); }
__device__ __forceinline__ float xmax32(float v) { const unsigned u = __float_as_uint(v); const auto r = __builtin_amdgcn_permlane32_swap(u, u, false, false); return fmaxf(__uint_as_float(r[0]), __uint_as_float(r[1])); }
__device__ __forceinline__ float xget16(float v, int lane) { const unsigned u = __float_as_uint(v); const auto r = __builtin_amdgcn_permlane16_swap(u, u, false, false); return __uint_as_float((lane & 16) ? r[0] : r[1]); }
__device__ __forceinline__ float xget32(float v, int lane) { const unsigned u = __float_as_uint(v); const auto r = __builtin_amdgcn_permlane32_swap(u, u, false, false); return __uint_as_float((lane & 32) ? r[0] : r[1]); }
typedef unsigned u32x2_t __attribute__((ext_vector_type(2)));
__device__ __forceinline__ void nt_store(const uint4& v, void* p) { __builtin_nontemporal_store(__builtin_bit_cast(pg8::u32x4, v), (pg8::u32x4*)p); }
__device__ __forceinline__ void nt_store(const uint2& v, void* p) { __builtin_nontemporal_store(__builtin_bit_cast(u32x2_t, v), (u32x2_t*)p); }
__device__ __forceinline__ void nt_store(const float4& v, void* p) { __builtin_nontemporal_store(__builtin_bit_cast(pg8::f32x4, v), (pg8::f32x4*)p); }
__device__ __forceinline__ uint4 nt_load16(const void* p) { return __builtin_bit_cast(uint4, __builtin_nontemporal_load((const pg8::u32x4*)p)); }
#define LDS_FENCE() asm volatile("s_waitcnt lgkmcnt(0)" ::: "memory")

__device__ __forceinline__ void ph_elem(const Params& p, int l, int tid, int bid, int nblk, int v0, int vend) {
    const int gtid = bid * NTHREADS + tid, GS = nblk * NTHREADS;
    const bf16* PROJ = (const bf16*)(p.ws + O_PROJ);
    const float* rc = (const float*)(p.ws + O_ROPE); const float* rs = rc + SEQ * 8;
    const int c8 = tid & 7;
    for (int idx0 = v0 + (gtid >> 3); idx0 < vend; idx0 += 4 * (GS >> 3)) {
        uint4 raw[4], res[4];
#pragma unroll
        for (int u = 0; u < 4; ++u) { const int idx = idx0 + u * (GS >> 3), t = idx / 6, j = idx - t * 6;
            const bf16* src = PROJ + (size_t)t * INP + ((j < 4) ? (C_NQ + 64 * j) : (j == 4) ? (C_NKV + 128) : (C_NKV + 256));
            raw[u] = (idx < vend) ? ((const uint4*)src)[c8] : make_uint4(0u, 0u, 0u, 0u); }
#pragma unroll
        for (int u = 0; u < 4; ++u) { const int idx = idx0 + u * (GS >> 3), t = idx / 6, j = idx - t * 6, s = t & (SEQ - 1);
            float v[8]; unpack8(raw[u], v);
            const float* w = ((j < 4) ? (p.nsa_q_norm_w + l * 64) : (p.nsa_k_norm_w + (size_t)l * 192 + ((j == 4) ? 64 : 128))) + 8 * c8;
            float ss = 0.f;
#pragma unroll
            for (int d = 0; d < 8; ++d) ss += v[d] * v[d];
            ss += __shfl_xor(ss, 1); ss += __shfl_xor(ss, 2); ss += __shfl_xor(ss, 4);
            const float rstd = rsqrtf(ss * (1.f / 64.f) + EPS);
#pragma unroll
            for (int d = 0; d < 8; ++d) v[d] = v[d] * rstd * w[d];
            float oth[8];
#pragma unroll
            for (int d = 0; d < 8; ++d) oth[d] = __shfl_xor(v[d], 1);
            if (c8 < 2 && idx < vend) {
#pragma unroll
                for (int d = 0; d < 8; ++d) { const float c = rc[s * 8 + d], sn = rs[s * 8 + d]; v[d] = (c8 == 0) ? (v[d] * c - oth[d] * sn) : (v[d] * c + oth[d] * sn); } }
            res[u].x = pk2(v[0], v[1]); res[u].y = pk2(v[2], v[3]); res[u].z = pk2(v[4], v[5]); res[u].w = pk2(v[6], v[7]); }
#pragma unroll
        for (int u = 0; u < 4; ++u) { const int idx = idx0 + u * (GS >> 3), t = idx / 6, j = idx - t * 6;
            bf16* dst = (j < 4) ? ((bf16*)(p.ws + O_QN) + (size_t)t * 256 + 64 * j) : (j == 4) ? ((bf16*)(p.ws + O_KS) + (size_t)t * 64) : ((bf16*)(p.ws + O_KW) + (size_t)t * 64);
            if (idx < vend) ((uint4*)dst)[c8] = res[u]; }
    }
}

__device__ __forceinline__ void ph_cmp_kv_fast(const Params& p, int l, unsigned char* smem, int tid, int lane, int wave, int item0, int istride) {
    const bf16* PROJ = (const bf16*)(p.ws + O_PROJ);
    bf16* KCMP = (bf16*)(p.ws + O_KCMP); bf16* VCMP = (bf16*)(p.ws + O_VCMP);
    const float* rc = (const float*)(p.ws + O_ROPE); const float* rs = rc + SEQ * 8;
    float* RED = (float*)smem;
    const int fr = lane & 15, fq = lane >> 4;
    for (int it = item0; it < BATCH * 2 * 8; it += istride) {
        const int rt = it & 7, kv = (it >> 3) & 1, b = it >> 4;
        const bf16* W2 = (const bf16*)(p.ws + O_WCT) + ((size_t)l * 2 + kv) * 64 * 2048;
        const int c = 16 * rt + fr;
        const int cc = (c > 126) ? 126 : c;
        const bf16* abase = PROJ + ((size_t)b * SEQ + 16 * cc) * INP + C_NKV + (kv ? 64 : 0);
        f32x4v acc[4];
#pragma unroll
        for (int nt = 0; nt < 4; ++nt) acc[nt] = (f32x4v){0.f, 0.f, 0.f, 0.f};
#pragma unroll 1
        for (int rd = 0; rd < 2; ++rd) {
            s16x8 a0v[2], a1v[2]; uint4 othv[2]; float4 rcv[2][2], rsv[2][2]; s16x8 wf[2][4][2];
#pragma unroll
            for (int ii = 0; ii < 2; ++ii) { const int i = 4 * wave + 2 * rd + ii; const bf16* ar = abase + (size_t)i * INP;
                a0v[ii] = *(const s16x8*)(ar + 8 * fq); a1v[ii] = *(const s16x8*)(ar + 32 + 8 * fq);
                if (kv == 0) { const int pos = 16 * cc + i; othv[ii] = *(const uint4*)(ar + 8 * ((fq ^ 1) & 1));
                    rcv[ii][0] = *(const float4*)(rc + pos * 8); rcv[ii][1] = *(const float4*)(rc + pos * 8 + 4); rsv[ii][0] = *(const float4*)(rs + pos * 8); rsv[ii][1] = *(const float4*)(rs + pos * 8 + 4); }
#pragma unroll
                for (int nt = 0; nt < 4; ++nt) { const bf16* wr = W2 + ((size_t)((2 * i) * 4 + nt) * 64 + lane) * 8; wf[ii][nt][0] = *(const s16x8*)wr; wf[ii][nt][1] = *(const s16x8*)(wr + 4 * 64 * 8); } }
#pragma unroll
            for (int ii = 0; ii < 2; ++ii) {
                s16x8 a0 = a0v[ii];
                if (kv == 0 && fq < 2) {
                    float own[8], oth[8]; unpack8(__builtin_bit_cast(uint4, a0), own); unpack8(othv[ii], oth);
                    const float cs[8] = {rcv[ii][0].x, rcv[ii][0].y, rcv[ii][0].z, rcv[ii][0].w, rcv[ii][1].x, rcv[ii][1].y, rcv[ii][1].z, rcv[ii][1].w};
                    const float sn[8] = {rsv[ii][0].x, rsv[ii][0].y, rsv[ii][0].z, rsv[ii][0].w, rsv[ii][1].x, rsv[ii][1].y, rsv[ii][1].z, rsv[ii][1].w};
                    float o8[8];
#pragma unroll
                    for (int e = 0; e < 8; ++e) o8[e] = (fq == 0) ? (own[e] * cs[e] - oth[e] * sn[e]) : (own[e] * cs[e] + oth[e] * sn[e]);
                    uint4 u; u.x = pk2(o8[0], o8[1]); u.y = pk2(o8[2], o8[3]); u.z = pk2(o8[4], o8[5]); u.w = pk2(o8[6], o8[7]);
                    a0 = __builtin_bit_cast(s16x8, u);
                }
#pragma unroll
                for (int nt = 0; nt < 4; ++nt) { acc[nt] = MFMA16(a0, wf[ii][nt][0], acc[nt]); acc[nt] = MFMA16(a1v[ii], wf[ii][nt][1], acc[nt]); }
            }
        }
        __syncthreads();
#pragma unroll
        for (int nt = 0; nt < 4; ++nt)
#pragma unroll
            for (int r = 0; r < 4; ++r) RED[(wave * 16 + 4 * fq + r) * 64 + 16 * nt + fr] = acc[nt][r];
        __syncthreads();
        {
            const int row = tid >> 5, c0 = 2 * (tid & 31);
            const float* pb = (const float*)(p.ws + O_PBIAS) + ((size_t)l * 2 + kv) * 64;
            float v0 = pb[c0], v1 = pb[c0 + 1];
#pragma unroll
            for (int w = 0; w < 8; ++w) { v0 += RED[(w * 16 + row) * 64 + c0]; v1 += RED[(w * 16 + row) * 64 + c0 + 1]; }
            float ss = v0 * v0 + v1 * v1;
#pragma unroll
            for (int o = 1; o < 32; o <<= 1) ss += __shfl_xor(ss, o);
            const int crow = 16 * rt + row;
            if (kv == 0) { const float rstd = rsqrtf(ss * (1.f / 64.f) + EPS); v0 *= rstd * p.nsa_k_norm_w[l * 192 + c0]; v1 *= rstd * p.nsa_k_norm_w[l * 192 + c0 + 1]; }
            if (crow == 127) { v0 = 0.f; v1 = 0.f; }
            *(unsigned*)(((kv == 0) ? KCMP : VCMP) + ((size_t)b * 128 + crow) * 64 + c0) = pk2(v0, v1);
        }
    }
}

__device__ __forceinline__ float scan128(float v, float* WT, int lane, int wave) {
#pragma unroll
    for (int o = 1; o < 64; o <<= 1) { const float t = __shfl_up(v, o); if (lane >= o) v += t; }
    if (lane == 63) WT[wave] = v;
    __syncthreads();
    return (wave & 1) ? v + WT[wave - 1] : v;
}
__device__ __forceinline__ void ph_ssd_p1(const Params& p, int l, unsigned char* smem, int tid, int lane, int wave, int item0, int istride) {
    constexpr int ST = 136;
    bf16* BT = (bf16*)smem;
    bf16* XdT = BT + 128 * ST;
    float* Acs = (float*)(XdT + 4 * 64 * ST);
    float* dts = Acs + 512;
    float* Araw = dts + 512;
    const bf16* PROJ = (const bf16*)(p.ws + O_PROJ); bf16* XBC = (bf16*)(p.ws + O_XBC); float* DT = (float*)(p.ws + O_DT);
    bf16* SLOC = (bf16*)(p.ws + O_SLOC); float* ATOT = (float*)(p.ws + O_ATOT);
    const float* cw = p.conv_w + (size_t)l * 4 * 1024; const float* cb = p.conv_b + (size_t)l * 1024;
    const int fr = lane & 15, fq = lane >> 4;
    for (int item = item0; item < BATCH * 16 * 2; item += istride) {
        const int g = item & 1, c = (item >> 1) & 15, b = item >> 5;
        const size_t t0 = (size_t)b * SEQ + 128 * c;
        __syncthreads();
        {   const int hh = tid >> 7, lrow = tid & 127, h = 4 * g + hh;
            const float dt = softplusf(bf2f(PROJ[(t0 + lrow) * INP + C_DT + h]) + p.dt_bias[l * 8 + h]);
            DT[(t0 + lrow) * 8 + h] = dt; dts[tid] = dt;
            const float s = scan128(dt * (-fexp(p.a_log[l * 8 + h])), Araw, lane, wave);
            Acs[tid] = s;
            if (lrow == 127) ATOT[((size_t)b * 16 + c) * 8 + 4 * g + hh] = s; }
        __syncthreads();
        {
            const int rg = lane & 7, cg = wave * 8 + (lane >> 3), r0 = 16 * rg;
            const int col = (cg < 32) ? (g * 256 + 8 * cg) : (cg < 48) ? (512 + g * 128 + 8 * (cg - 32)) : (768 + g * 128 + 8 * (cg - 48));
            float wv[4][8], bv[8];
#pragma unroll
            for (int k = 0; k < 4; ++k) { const float4 w0 = *(const float4*)(cw + k * 1024 + col), w1 = *(const float4*)(cw + k * 1024 + col + 4);
                wv[k][0] = w0.x; wv[k][1] = w0.y; wv[k][2] = w0.z; wv[k][3] = w0.w; wv[k][4] = w1.x; wv[k][5] = w1.y; wv[k][6] = w1.z; wv[k][7] = w1.w; }
            { const float4 b0 = *(const float4*)(cb + col), b1 = *(const float4*)(cb + col + 4); bv[0] = b0.x; bv[1] = b0.y; bv[2] = b0.z; bv[3] = b0.w; bv[4] = b1.x; bv[5] = b1.y; bv[6] = b1.z; bv[7] = b1.w; }
            const int hh = (cg >> 3) & 3;
            const float atot = Acs[hh * 128 + 127];
            bf16* tb = (cg < 32) ? (XdT + (hh * 64 + ((8 * cg) & 63)) * ST) : (BT + (8 * (cg & 15)) * ST);
#pragma unroll 1
            for (int half = 0; half < 2; ++half) {
                uint4 in[11];
#pragma unroll
                for (int i = 0; i < 11; ++i) { const int rr = r0 + 8 * half - 3 + i, ts = 128 * c + rr;
                    in[i] = (ts >= 0) ? *(const uint4*)(PROJ + (t0 + rr) * INP + C_XBC + col) : make_uint4(0u, 0u, 0u, 0u); }
                float xw[4][8];
                unpack8(in[0], xw[0]); unpack8(in[1], xw[1]); unpack8(in[2], xw[2]);
                unsigned op[8][4];
#pragma unroll
                for (int ii = 0; ii < 8; ++ii) { const int i = ii, row = r0 + 8 * half + ii;
                    unpack8(in[i + 3], xw[(i + 3) & 3]);
                    float acc[8];
#pragma unroll
                    for (int e = 0; e < 8; ++e) { acc[e] = bv[e];
#pragma unroll
                        for (int k = 0; k < 4; ++k) acc[e] += wv[k][e] * xw[(i + k) & 3][e];
                        acc[e] = siluf(acc[e]); }
                    uint4 o; o.x = pk2(acc[0], acc[1]); o.y = pk2(acc[2], acc[3]); o.z = pk2(acc[4], acc[5]); o.w = pk2(acc[6], acc[7]);
                    *(uint4*)(XBC + (t0 + row) * 1024 + col) = o;
                    if (cg < 48) {
                        float f[8]; unpack8(o, f);
                        const float sc = (cg < 32) ? dts[hh * 128 + row] * fexp(atot - Acs[hh * 128 + row]) : 1.f;
#pragma unroll
                        for (int e = 0; e < 8; ++e) { const unsigned hv = (unsigned)f2bf(f[e] * sc); op[e][ii >> 1] = (ii & 1) ? (op[e][ii >> 1] | (hv << 16)) : hv; } }
                    __builtin_amdgcn_sched_barrier(0);
                }
                if (cg < 48) {
#pragma unroll
                    for (int e = 0; e < 8; ++e) *(uint4*)(tb + e * ST + r0 + 8 * half) = make_uint4(op[e][0], op[e][1], op[e][2], op[e][3]); }
            }
        }
        __syncthreads();
        {
            const int hh = wave >> 1, ntb = 4 * (wave & 1), h = 4 * g + hh;
            bf16* dst = SLOC + (((size_t)b * 16 + c) * 8 + h) * 8192;
#pragma unroll
            for (int mt = 0; mt < 4; ++mt) {
                s16x8 xf[4];
#pragma unroll
                for (int ks = 0; ks < 4; ++ks) xf[ks] = ldfrag(XdT + hh * 64 * ST, ST, 16 * mt, 32 * ks, lane);
#pragma unroll
                for (int j = 0; j < 4; ++j) { f32x4v a = {0.f, 0.f, 0.f, 0.f};
#pragma unroll
                    for (int ks = 0; ks < 4; ++ks) a = MFMA16(ldfrag(BT, ST, 16 * (ntb + j), 32 * ks, lane), xf[ks], a);
                    *(uint2*)(dst + (16 * mt + fr) * 128 + 16 * (ntb + j) + 4 * fq) = make_uint2(pk2(a[0], a[1]), pk2(a[2], a[3])); }
            }
        }
    }
}
__device__ __forceinline__ void ph_ssd_scan(const Params& p, int tid) {
    const int gtid = blockIdx.x * NTHREADS + tid, GS = gridDim.x * NTHREADS;
    const bf16* SLOC = (const bf16*)(p.ws + O_SLOC); const float* ATOT = (const float*)(p.ws + O_ATOT); bf16* SIN = (bf16*)(p.ws + O_SIN);
    for (int i = gtid; i < BATCH * 8 * 2048; i += GS) {
        const int e4 = i & 2047, h = (i >> 11) & 7, b = i >> 14;
        float4 v[15]; float at[15];
#pragma unroll
        for (int c = 0; c < 15; ++c) { const uint2 q = *(const uint2*)(SLOC + (((size_t)b * 16 + c) * 8 + h) * 8192 + 4 * e4);
            v[c] = make_float4(__uint_as_float(q.x << 16), __uint_as_float(q.x & 0xffff0000u), __uint_as_float(q.y << 16), __uint_as_float(q.y & 0xffff0000u)); at[c] = ATOT[((size_t)b * 16 + c) * 8 + h]; }
        float4 s = {0.f, 0.f, 0.f, 0.f};
        *(uint2*)(SIN + (((size_t)b * 16 + 0) * 8 + h) * 8192 + 4 * e4) = make_uint2(0u, 0u);
#pragma unroll
        for (int c = 0; c < 15; ++c) { const float w = fexp(at[c]); s.x = s.x * w + v[c].x; s.y = s.y * w + v[c].y; s.z = s.z * w + v[c].z; s.w = s.w * w + v[c].w;
            *(uint2*)(SIN + (((size_t)b * 16 + c + 1) * 8 + h) * 8192 + 4 * e4) = make_uint2(pk2(s.x, s.y), pk2(s.z, s.w)); }
    }
}
__device__ __forceinline__ void ph_ssd_p2(const Params& p, int l, unsigned char* smem, int tid, int lane, int wave, int item0, int istride) {
    constexpr int ST = 136;
    bf16* Cs = (bf16*)smem; bf16* Bs = Cs + 128 * ST; bf16* XT = Bs + 128 * ST; bf16* Ss = XT + 64 * ST;
    float* Acs = (float*)(Ss + 64 * ST); float* dts = Acs + 512; float* Araw = dts + 512;
    const bf16* PROJ = (const bf16*)(p.ws + O_PROJ); const bf16* XBC = (const bf16*)(p.ws + O_XBC); const float* DT = (const float*)(p.ws + O_DT);
    const float* SLOC = (const float*)(p.ws + O_SLOC); const float* ATOT = (const float*)(p.ws + O_ATOT);
    bf16* MIX = (bf16*)(p.ws + O_MIX);
    const int fr = lane & 15, fq = lane >> 4;
    for (int item = item0; item < BATCH * 16 * 2; item += istride) {
        const int g = item & 1, c = 15 - ((item >> 1) & 15), b = item >> 5;
        const size_t t0 = (size_t)b * SEQ + 128 * c;
        __syncthreads();
#pragma unroll
        for (int i = 0; i < 4; ++i) { const int idx = tid + NTHREADS * i, row = idx >> 4, c16 = idx & 15;
            *(uint4*)(Cs + row * ST + 8 * c16) = *(const uint4*)(XBC + (t0 + row) * 1024 + 768 + g * 128 + 8 * c16);
            *(uint4*)(Bs + row * ST + 8 * c16) = *(const uint4*)(XBC + (t0 + row) * 1024 + 512 + g * 128 + 8 * c16); }
        {   const int hh = tid >> 7, lrow = tid & 127, h = 4 * g + hh; const float dt = DT[(t0 + lrow) * 8 + h];
            dts[tid] = dt; Acs[tid] = scan128(dt * (-fexp(p.a_log[l * 8 + h])), Araw, lane, wave); }
        s16x8 af[4];
#pragma unroll
        for (int ks = 0; ks < 4; ++ks) af[ks] = ldfrag(Cs, ST, 16 * wave, 32 * ks, lane);
        f32x4v gacc[8];
#pragma unroll
        for (int st = 0; st < 8; ++st) { gacc[st] = (f32x4v){0.f, 0.f, 0.f, 0.f};
            if (st <= wave) {
#pragma unroll
                for (int ks = 0; ks < 4; ++ks) gacc[st] = MFMA16(af[ks], ldfrag(Bs, ST, 16 * st, 32 * ks, lane), gacc[st]); } }
        uint4 ns0, ns1, nx0, nx1;
#define P2_PREFETCH(HH) do { const int h_ = 4 * g + (HH); const uint4* s4_ = (const uint4*)((const bf16*)(p.ws + O_SIN) + (((size_t)b * 16 + c) * 8 + h_) * 8192 + tid * 16); ns0 = s4_[0]; ns1 = s4_[1]; \
            nx0 = *(const uint4*)(XBC + (t0 + (tid >> 3)) * 1024 + h_ * 64 + 8 * (tid & 7)); nx1 = *(const uint4*)(XBC + (t0 + 64 + (tid >> 3)) * 1024 + h_ * 64 + 8 * (tid & 7)); } while (0)
        P2_PREFETCH(0);
#pragma unroll 1
        for (int hh = 0; hh < 4; ++hh) {
            const int h = 4 * g + hh;
            __syncthreads();
            *(uint4*)(Ss + (tid >> 3) * ST + 16 * (tid & 7)) = ns0; *(uint4*)(Ss + (tid >> 3) * ST + 16 * (tid & 7) + 8) = ns1;
#pragma unroll
            for (int i = 0; i < 2; ++i) { const int row = (tid >> 3) + 64 * i, c8 = tid & 7;
                float f[8]; unpack8(i ? nx1 : nx0, f); const float dt = dts[hh * 128 + row];
#pragma unroll
                for (int e = 0; e < 8; ++e) XT[(8 * c8 + e) * ST + (row ^ (c8 << 3))] = f2bf(f[e] * dt); }
            if (hh < 3) P2_PREFETCH(hh + 1);
            float acl[4];
#pragma unroll
            for (int r = 0; r < 4; ++r) acl[r] = Acs[hh * 128 + 16 * wave + 4 * fq + r];
            {
                bf16* Ms = Bs;
#pragma unroll
                for (int st = 0; st < 8; ++st) { if (st <= (wave | 1)) {
                    const int s = 16 * st + fr; const float acs_s = Acs[hh * 128 + s];
#pragma unroll
                    for (int r = 0; r < 4; ++r) { const int lrow = 16 * wave + 4 * fq + r;
                        const float v = (s <= lrow) ? gacc[st][r] * fexp(acl[r] - acs_s) : 0.f;
                        Ms[lrow * ST + s] = f2bf(v); } } }
            }
            __syncthreads();
            {
                const bf16* Ms = Bs;
                f32x4v yd[4], yo[4];
#pragma unroll
                for (int pt = 0; pt < 4; ++pt) { yd[pt] = (f32x4v){0.f, 0.f, 0.f, 0.f}; yo[pt] = (f32x4v){0.f, 0.f, 0.f, 0.f}; }
                const size_t t = t0 + 16 * wave + fr;
                uint2 xqa[4], zqa[4];
#pragma unroll
                for (int pt = 0; pt < 4; ++pt) { const int col = h * 64 + 16 * pt + 4 * fq; xqa[pt] = *(const uint2*)(XBC + t * 1024 + col); zqa[pt] = *(const uint2*)(PROJ + t * INP + C_Z + col); }
#pragma unroll
                for (int ks = 0; ks < 4; ++ks) {
                    if (2 * ks <= wave) { const s16x8 mf = ldfrag(Ms, ST, 16 * wave, 32 * ks, lane);
#pragma unroll
                        for (int pt = 0; pt < 4; ++pt) yd[pt] = MFMA16(ldfrag_sw8(XT, ST, 16 * pt, 32 * ks, lane), mf, yd[pt]); }
#pragma unroll
                    for (int pt = 0; pt < 4; ++pt) yo[pt] = MFMA16(ldfrag(Ss, ST, 16 * pt, 32 * ks, lane), af[ks], yo[pt]); }
                const float dsk = p.d_skip[l * 8 + h];
                const float ea = fexp(Acs[hh * 128 + 16 * wave + fr]);
#pragma unroll
                for (int pt = 0; pt < 4; ++pt) { const int col = h * 64 + 16 * pt + 4 * fq;
                    const uint2 xq = xqa[pt], zq = zqa[pt];
                    const float xs[4] = {__uint_as_float(xq.x << 16), __uint_as_float(xq.x & 0xffff0000u), __uint_as_float(xq.y << 16), __uint_as_float(xq.y & 0xffff0000u)};
                    const float zz[4] = {__uint_as_float(zq.x << 16), __uint_as_float(zq.x & 0xffff0000u), __uint_as_float(zq.y << 16), __uint_as_float(zq.y & 0xffff0000u)};
                    float y[4];
#pragma unroll
                    for (int e = 0; e < 4; ++e) y[e] = (yd[pt][e] + ea * yo[pt][e] + dsk * xs[e]) * siluf(zz[e]);
                    *(uint2*)(MIX + t * 1024 + col) = make_uint2(pk2(y[0], y[1]), pk2(y[2], y[3])); }
            }
        }
    }
}

#ifndef SB_EXIT_THR
#define SB_EXIT_THR (-40.f)
#endif
__device__ __forceinline__ void ph_sb_fast(const Params& p, unsigned char* smem, int tid, int lane, int wave, int item0, int istride) {
    constexpr int ST = 72;
    bf16* KB0 = (bf16*)smem; volatile int* FLG = (volatile int*)(KB0 + 4 * 64 * ST);
    const bf16* PROJ = (const bf16*)(p.ws + O_PROJ); bf16* MIX = (bf16*)(p.ws + O_MIX);
    const int fr = lane & 15, fq = lane >> 4;
    const auto sb_store = [&](bf16* Kd, bf16* Vd, const uint4& kv, const uint4& vv) { const int row = tid >> 3, c8 = tid & 7;
        *(uint4*)(Kd + row * ST + 8 * c8) = kv;
        const unsigned vw[4] = {vv.x, vv.y, vv.z, vv.w};
#pragma unroll
        for (int e = 0; e < 8; ++e) Vd[(8 * c8 + e) * ST + (row ^ vt_swz(c8))] = (bf16)((e & 1) ? (vw[e >> 1] >> 16) : (vw[e >> 1] & 0xffffu)); };
    for (int item = item0; item < BATCH * 4 * 16; item += istride) {
        const int bi = item & 255, sec = item >> 8, k63 = bi & 63, side = (k63 >= 32) ? 1 : 0, dd = side ? 63 - k63 : k63, dp = 7 - (dd >> 2), kp = side ? 15 - dp : dp, hb = (bi >> 6) * 4 + (dd & 3);
        const int qt = sec ? kp : 15 - kp, h = hb & 3, b = (hb >> 2) + 4 * sec;
        const size_t rowb = (size_t)b * SEQ;
        s16x8 qf[2];
#pragma unroll
        for (int ks = 0; ks < 2; ++ks) qf[ks] = *(const s16x8*)(PROJ + (rowb + 128 * qt + 16 * wave + fr) * INP + C_SB + h * 64 + 32 * ks + 8 * fq);
        const int t = 128 * qt + 16 * wave + fr;
        f32x4v o[4];
#pragma unroll
        for (int dt = 0; dt < 4; ++dt) o[dt] = (f32x4v){0.f, 0.f, 0.f, 0.f};
        float R = 0.f;
        if (tid == 0) { FLG[0] = 0; FLG[1] = 0; FLG[2] = 0; }
        uint4 nk, nv;
        { const bf16* src = PROJ + (rowb + 64 * (2 * qt + 1) + (tid >> 3)) * INP + C_SB + 256 + h * 64 + 8 * (tid & 7); nk = *(const uint4*)src; nv = *(const uint4*)(src + 256); }
        __syncthreads();
        sb_store(KB0, KB0 + 64 * ST, nk, nv);
        { const bf16* src = PROJ + (rowb + 64 * (2 * qt) + (tid >> 3)) * INP + C_SB + 256 + h * 64 + 8 * (tid & 7); nk = *(const uint4*)src; nv = *(const uint4*)(src + 256); }
        __syncthreads();
        int itn = 0;
#pragma unroll 1
        for (int kt = 2 * qt + 1; kt >= 0; --kt, ++itn) {
            bf16* Ks = KB0 + (itn & 1) * (2 * 64 * ST); bf16* VT = Ks + 64 * ST; bf16* Kn = KB0 + ((itn & 1) ^ 1) * (2 * 64 * ST); bf16* Vn = Kn + 64 * ST;
            const int fcur = itn % 3, fnxt = (itn + 1) % 3;
            if (tid == 0) FLG[fnxt] = 0;
            const auto stage = [&]() { if (kt > 0) { sb_store(Kn, Vn, nk, nv);
                if (kt > 1) { const bf16* src = PROJ + (rowb + 64 * (kt - 2) + (tid >> 3)) * INP + C_SB + 256 + h * 64 + 8 * (tid & 7); nk = *(const uint4*)src; nv = *(const uint4*)(src + 256); } } };
            const auto sb_tile = [&](auto itag) { constexpr bool interior = decltype(itag)::value;
            f32x4v st[4];
#pragma unroll
            for (int mt = 0; mt < 4; ++mt) { st[mt] = (f32x4v){0.f, 0.f, 0.f, 0.f};
#pragma unroll
                for (int ks = 0; ks < 2; ++ks) st[mt] = MFMA16(ldfrag(Ks, ST, 16 * mt, 32 * ks, lane), qf[ks], st[mt]); }
            stage();
            float z[16], ls[16], T[4], E[4], C[4];
#pragma unroll
            for (int mt = 0; mt < 4; ++mt) { T[mt] = 0.f;
#pragma unroll
                for (int r = 0; r < 4; ++r) { const int key = 64 * kt + 16 * mt + 4 * fq + r; z[4 * mt + r] = st[mt][r] * 0.125f;
                    ls[4 * mt + r] = (interior || key < t) ? -softplus_fast(z[4 * mt + r]) : 0.f; T[mt] += ls[4 * mt + r]; }
                const float a1 = xget16(T[mt], lane), a2 = xget32(T[mt], lane), a3 = xget32(a1, lane);
                E[mt] = (((fq ^ 1) > fq) ? a1 : 0.f) + (((fq ^ 2) > fq) ? a2 : 0.f) + (((fq ^ 3) > fq) ? a3 : 0.f);
                C[mt] = T[mt] + a1 + a2 + a3; }
            unsigned pw[8];
            {
                float base = R;
#pragma unroll
                for (int mt = 3; mt >= 0; --mt) { float inl = base + E[mt]; float wv[4];
#pragma unroll
                    for (int r = 3; r >= 0; --r) { const int key = 64 * kt + 16 * mt + 4 * fq + r; inl += ls[4 * mt + r];
                        wv[r] = (interior || key < t) ? fexp(z[4 * mt + r] + inl) : 0.f; }
                    pw[2 * mt] = pk2(wv[0], wv[1]); pw[2 * mt + 1] = pk2(wv[2], wv[3]);
                    base += C[mt]; }
                R = base;
            }
#pragma unroll
            for (int s2 = 0; s2 < 2; ++s2) { const s16x8 pb = __builtin_bit_cast(s16x8, make_uint4(pw[4 * s2], pw[4 * s2 + 1], pw[4 * s2 + 2], pw[4 * s2 + 3]));
#pragma unroll
                for (int dt = 0; dt < 4; ++dt) o[dt] = MFMA16(ldfrag_perm(VT, ST, 16 * dt, 32 * s2, lane), pb, o[dt]); }
            };
            if (kt < 2 * qt) sb_tile(std::true_type{}); else sb_tile(std::false_type{});
            const int done = (R < SB_EXIT_THR) ? 1 : 0;
            if (!__all(done) && lane == 0) FLG[fcur] = 1;
            __syncthreads();
            if (FLG[fcur] == 0) break;
        }
#pragma unroll
        for (int dt = 0; dt < 4; ++dt) *(uint2*)(MIX + (rowb + t) * 1024 + 512 + h * 64 + 16 * dt + 4 * fq) = make_uint2(pk2(o[dt][0], o[dt][1]), pk2(o[dt][2], o[dt][3]));
        __syncthreads();
    }
}

struct NsaLds { bf16* Ks; bf16* VT; bf16* Ps; float* PF; float* IMP; unsigned char* SELB; };
__device__ __forceinline__ void nsa_load(uint4& kv, uint4& vv, const bf16* kbase, int kst, const bf16* vbase, int vst, int tid) {
    const int row = tid >> 3, c8 = tid & 7;
    kv = *(const uint4*)(kbase + (size_t)row * kst + 8 * c8); vv = *(const uint4*)(vbase + (size_t)row * vst + 8 * c8);
}
__device__ __forceinline__ void nsa_store(bf16* Ks, bf16* VT, const uint4& kv, const uint4& vv, int tid) {
    const int row = tid >> 3, c8 = tid & 7;
    *(uint4*)(Ks + row * 72 + 8 * c8) = kv;
    const unsigned vw[4] = {vv.x, vv.y, vv.z, vv.w};
#pragma unroll
    for (int e = 0; e < 8; ++e) VT[(8 * c8 + e) * 136 + (row ^ vt_swz(c8))] = (bf16)((e & 1) ? (vw[e >> 1] >> 16) : (vw[e >> 1] & 0xffffu));
}
template <bool UNI, class Mask, class Mid>
__device__ __forceinline__ void nsa_tile_t(const bf16* Ks, const bf16* VT, const s16x8 (&qf)[2], f32x4v (&ot)[4], float& m, float& lpart, int lane, const Mask& allowed, const bool lane_ok, const Mid& mid) {
    constexpr float SC = 0.125f * 1.44269504088896341f;
    const int fq = lane >> 4;
    f32x4v st[4];
#pragma unroll
    for (int mt = 0; mt < 4; ++mt) { st[mt] = (f32x4v){0.f, 0.f, 0.f, 0.f};
#pragma unroll
        for (int ks = 0; ks < 2; ++ks) st[mt] = MFMA16(ldfrag(Ks, 72, 16 * mt, 32 * ks, lane), qf[ks], st[mt]); }
    mid();
    bool ok[16]; float tm = -1e30f;
#pragma unroll
    for (int mt = 0; mt < 4; ++mt)
#pragma unroll
        for (int r = 0; r < 4; ++r) {
            if constexpr (UNI) { ok[4 * mt + r] = true; tm = fmaxf(tm, st[mt][r]); }
            else { ok[4 * mt + r] = allowed(16 * mt + 4 * fq + r); tm = fmaxf(tm, ok[4 * mt + r] ? st[mt][r] : -1e30f); } }
    if constexpr (UNI) tm = lane_ok ? tm : -1e30f;
    tm = xmax32(xmax16(tm));
    const float mn = fmaxf(m, tm), alpha = __builtin_amdgcn_exp2f((m - mn) * SC), nb = (UNI && !lane_ok) ? -1e30f : -mn * SC; m = mn;
    float ps = 0.f; unsigned pw[8];
#pragma unroll
    for (int mt = 0; mt < 4; ++mt) { float pv[4];
#pragma unroll
        for (int r = 0; r < 4; ++r) { const float ev = __builtin_amdgcn_exp2f(__builtin_fmaf(st[mt][r], SC, nb)); pv[r] = (UNI || ok[4 * mt + r]) ? ev : 0.f; ps += pv[r]; }
        pw[2 * mt] = pk2(pv[0], pv[1]); pw[2 * mt + 1] = pk2(pv[2], pv[3]); }
    lpart = lpart * alpha + ps;
#pragma unroll
    for (int dt = 0; dt < 4; ++dt) ot[dt] = ot[dt] * alpha;
#pragma unroll
    for (int s = 0; s < 2; ++s) { const s16x8 pb = __builtin_bit_cast(s16x8, make_uint4(pw[4 * s], pw[4 * s + 1], pw[4 * s + 2], pw[4 * s + 3]));
#pragma unroll
        for (int dt = 0; dt < 4; ++dt) ot[dt] = MFMA16(ldfrag_perm(VT, 136, 16 * dt, 32 * s, lane), pb, ot[dt]); }
}
__device__ __forceinline__ void ph_nsa_t(const Params& p, unsigned char* smem, int tid, int lane, int wave, int item0, int istride) {
    NsaLds L;
    L.Ks = (bf16*)smem; L.VT = L.Ks + 128 * 72; L.Ps = L.VT + 64 * 136; L.PF = (float*)(L.Ps + 128 * 136); L.IMP = L.PF + 4 * 32 * 129;     L.SELB = (unsigned char*)(L.IMP + 32 * 33);
    const bf16* PROJ = (const bf16*)(p.ws + O_PROJ); const bf16* QN = (const bf16*)(p.ws + O_QN);
    const bf16* KS = (const bf16*)(p.ws + O_KS); const bf16* KW = (const bf16*)(p.ws + O_KW);
    const bf16* KCMP = (const bf16*)(p.ws + O_KCMP); const bf16* VCMP = (const bf16*)(p.ws + O_VCMP);
    bf16* MIX = (bf16*)(p.ws + O_MIX);
    const int fr = lane & 15, fq = lane >> 4, hh = wave >> 1, qs = (wave & 1) * 16;
    for (int item = item0; item < BATCH * 64; item += istride) {
        const int qt = (item < 256) ? 63 - (item & 63) : (item & 63), b = item >> 6, blk = qt >> 1;
        const size_t rowb = (size_t)b * SEQ;
        const int tq = 32 * qt + qs + fr;
        s16x8 qf[2];
#pragma unroll
        for (int ks = 0; ks < 2; ++ks) qf[ks] = *(const s16x8*)(QN + (rowb + tq) * 256 + hh * 64 + 32 * ks + 8 * fq);
        const bf16* gp = PROJ + (rowb + tq) * INP + C_GATE + hh * 3;
        const float g0 = sigmoidf_(bf2f(gp[0])), g1 = sigmoidf_(bf2f(gp[1])), g2 = sigmoidf_(bf2f(gp[2]));
        f32x4v out[4];
        __syncthreads();
#pragma unroll
        for (int i = 0; i < 2; ++i) { const int idx = tid + NTHREADS * i, row = idx >> 3, c8 = idx & 7;
            const uint4 kv = *(const uint4*)(KCMP + ((size_t)b * 128 + row) * 64 + 8 * c8), vv = *(const uint4*)(VCMP + ((size_t)b * 128 + row) * 64 + 8 * c8);
            *(uint4*)(L.Ks + row * 72 + 8 * c8) = kv;
            const unsigned vw[4] = {vv.x, vv.y, vv.z, vv.w};
#pragma unroll
            for (int e = 0; e < 8; ++e) L.VT[(8 * c8 + e) * 136 + (row ^ vt_swz(c8))] = (bf16)((e & 1) ? (vw[e >> 1] >> 16) : (vw[e >> 1] & 0xffffu)); }
        __syncthreads();
        {
            f32x4v st[8];
#pragma unroll
            for (int mt = 0; mt < 8; ++mt) { st[mt] = (f32x4v){0.f, 0.f, 0.f, 0.f};
#pragma unroll
                for (int ks = 0; ks < 2; ++ks) st[mt] = MFMA16(ldfrag(L.Ks, 72, 16 * mt, 32 * ks, lane), qf[ks], st[mt]); }
            float e[32]; float tm = -1e30f;
#pragma unroll
            for (int mt = 0; mt < 8; ++mt)
#pragma unroll
                for (int r = 0; r < 4; ++r) { e[4 * mt + r] = st[mt][r] * 0.125f; const bool vis = (16 * (16 * mt + 4 * fq + r) + 31 <= tq); tm = fmaxf(tm, vis ? e[4 * mt + r] : -1e30f); }
            tm = xmax32(xmax16(tm));
            float ps = 0.f;
#pragma unroll
            for (int mt = 0; mt < 8; ++mt)
#pragma unroll
                for (int r = 0; r < 4; ++r) { const bool vis = (16 * (16 * mt + 4 * fq + r) + 31 <= tq); e[4 * mt + r] = vis ? fexp(e[4 * mt + r] - tm) : 0.f; ps += e[4 * mt + r]; }
            ps = xsum32(xsum16(ps));
            const float inv = (ps > 0.f) ? 1.f / ps : 0.f;
            unsigned pw[16];
#pragma unroll
            for (int mt = 0; mt < 8; ++mt) {
#pragma unroll
                for (int r = 0; r < 4; ++r) { e[4 * mt + r] *= inv; L.PF[(hh * 32 + qs + fr) * 129 + 16 * mt + 4 * fq + r] = e[4 * mt + r]; }
                pw[2 * mt] = pk2(e[4 * mt], e[4 * mt + 1]); pw[2 * mt + 1] = pk2(e[4 * mt + 2], e[4 * mt + 3]); }
            f32x4v oc[4];
#pragma unroll
            for (int dt = 0; dt < 4; ++dt) oc[dt] = (f32x4v){0.f, 0.f, 0.f, 0.f};
#pragma unroll
            for (int s = 0; s < 4; ++s) { const s16x8 pb = __builtin_bit_cast(s16x8, make_uint4(pw[4 * s], pw[4 * s + 1], pw[4 * s + 2], pw[4 * s + 3]));
#pragma unroll
                for (int dt = 0; dt < 4; ++dt) oc[dt] = MFMA16(ldfrag_perm(L.VT, 136, 16 * dt, 32 * s, lane), pb, oc[dt]); }
#pragma unroll
            for (int dt = 0; dt < 4; ++dt) out[dt] = oc[dt] * g0;
        }
        __syncthreads();
        if (blk >= 16) {
            const int q = tid >> 4, jj = tid & 15;
#pragma unroll
            for (int half = 0; half < 2; ++half) { const int j = jj + 16 * half;
                const int c0 = (4 * j - 1 < 0) ? 0 : 4 * j - 1, c1 = (4 * j + 3 > 126) ? 126 : 4 * j + 3;
                float a = 0.f;
                for (int c = c0; c <= c1; ++c) for (int h4 = 0; h4 < 4; ++h4) a += L.PF[(h4 * 32 + q) * 129 + c];
                L.IMP[q * 33 + j] = a; }
        }
        __syncthreads();
        {
            const int q = tid >> 4, jj = tid & 15;
            int r0 = 0, r1 = 0;
            if (blk >= 16) { const float m0 = L.IMP[q * 33 + jj], m1 = L.IMP[q * 33 + jj + 16];
#pragma unroll
                for (int j2 = 1; j2 < 30; ++j2) { const float ov = L.IMP[q * 33 + j2]; const bool in = j2 <= blk - 2;
                    r0 += (in && (ov > m0 || (ov == m0 && j2 < jj))) ? 1 : 0; r1 += (in && (ov > m1 || (ov == m1 && j2 < jj + 16))) ? 1 : 0; } }
#pragma unroll
            for (int half = 0; half < 2; ++half) { const int j = jj + 16 * half;
                bool sel;
                if (blk < 16) sel = (j <= blk);
                else if (j == 0 || j == blk || j == blk - 1) sel = true;
                else if (j > blk) sel = false;
                else sel = (half ? r1 : r0) < 13;
                L.SELB[q * 32 + j] = sel ? 1 : 0; }
        }
        {
            f32x4v o[4]; float m = -1e30f, lp = 0.f;
#pragma unroll
            for (int dt = 0; dt < 4; ++dt) o[dt] = (f32x4v){0.f, 0.f, 0.f, 0.f};
            uint4 nk, nv;
            nsa_load(nk, nv, KS + rowb * 64, 64, PROJ + rowb * INP + C_NKV + 192, INP, tid);
            __syncthreads();
            nsa_store(L.Ks, L.VT, nk, nv, tid);
            if (blk > 0) nsa_load(nk, nv, KS + (rowb + 64) * 64, 64, PROJ + (rowb + 64) * INP + C_NKV + 192, INP, tid);
            __syncthreads();
#pragma unroll 1
            for (int j = 0; j <= blk; ++j) {
                const bool odd = j & 1;
                bf16* Kc = odd ? L.Ps : L.Ks; bf16* Vc = odd ? (L.Ps + 64 * 72) : L.VT; bf16* Kn = odd ? L.Ks : L.Ps; bf16* Vn = odd ? L.VT : (L.Ps + 64 * 72);
                const bool sb = L.SELB[(qs + fr) * 32 + j] != 0;
                const auto stage = [&]() { if (j < blk) { nsa_store(Kn, Vn, nk, nv, tid);
                    if (j + 1 < blk) nsa_load(nk, nv, KS + (rowb + 64 * (j + 2)) * 64, 64, PROJ + (rowb + 64 * (j + 2)) * INP + C_NKV + 192, INP, tid); } };
                if (j < blk) nsa_tile_t<true>(Kc, Vc, qf, o, m, lp, lane, [&](int) { return true; }, sb, stage);
                else nsa_tile_t<false>(Kc, Vc, qf, o, m, lp, lane, [&](int kk) { return sb && (64 * j + kk <= tq); }, true, stage);
                __syncthreads();
            }
            lp = xsum32(xsum16(lp));
            const float sc = g1 / lp;
#pragma unroll
            for (int dt = 0; dt < 4; ++dt) out[dt] = out[dt] + o[dt] * sc;
        }
        {
            f32x4v o[4]; float m = -1e30f, lp = 0.f;
#pragma unroll
            for (int dt = 0; dt < 4; ++dt) o[dt] = (f32x4v){0.f, 0.f, 0.f, 0.f};
            const int klo = (32 * qt - 511 < 0) ? 0 : ((32 * qt - 511) >> 6);
            uint4 nk, nv;
            nsa_load(nk, nv, KW + (rowb + 64 * klo) * 64, 64, PROJ + (rowb + 64 * klo) * INP + C_NKV + 320, INP, tid);
            nsa_store(L.Ks, L.VT, nk, nv, tid);
            if (klo < blk) nsa_load(nk, nv, KW + (rowb + 64 * (klo + 1)) * 64, 64, PROJ + (rowb + 64 * (klo + 1)) * INP + C_NKV + 320, INP, tid);
            __syncthreads();
#pragma unroll 1
            for (int j = klo; j <= blk; ++j) {
                const bool odd = (j - klo) & 1;
                bf16* Kc = odd ? L.Ps : L.Ks; bf16* Vc = odd ? (L.Ps + 64 * 72) : L.VT; bf16* Kn = odd ? L.Ks : L.Ps; bf16* Vn = odd ? L.VT : (L.Ps + 64 * 72);
                const auto stage = [&]() { if (j < blk) { nsa_store(Kn, Vn, nk, nv, tid);
                    if (j + 1 < blk) nsa_load(nk, nv, KW + (rowb + 64 * (j + 2)) * 64, 64, PROJ + (rowb + 64 * (j + 2)) * INP + C_NKV + 320, INP, tid); } };
                if (64 * j + 63 <= 32 * qt && 32 * qt + 31 - 64 * j < 512) nsa_tile_t<true>(Kc, Vc, qf, o, m, lp, lane, [&](int) { return true; }, true, stage);
                else nsa_tile_t<false>(Kc, Vc, qf, o, m, lp, lane, [&](int kk) { const int key = 64 * j + kk; return key <= tq && tq - key < 512; }, true, stage);
                __syncthreads();
            }
            lp = xsum32(xsum16(lp));
            const float sc = g2 / lp;
#pragma unroll
            for (int dt = 0; dt < 4; ++dt) out[dt] = out[dt] + o[dt] * sc;
        }
#pragma unroll
        for (int dt = 0; dt < 4; ++dt) *(uint2*)(MIX + (rowb + tq) * 1024 + 768 + hh * 64 + 16 * dt + 4 * fq) = make_uint2(pk2(out[dt][0], out[dt][1]), pk2(out[dt][2], out[dt][3]));
    }
}

__device__ __forceinline__ void ph_mixnorm(const Params& p, int l, int lane, int wave) {
    const int gw = blockIdx.x * 8 + wave, NGW = gridDim.x * 8;
    const bf16* MIX = (const bf16*)(p.ws + O_MIX); bf16* MIXN = (bf16*)(p.ws + O_MIXN);
    const int grp = (lane < 32) ? 0 : (lane < 48) ? 1 : 2;
    const float* w = (grp == 0) ? (p.ssd_norm_w + l * 512 + 16 * lane) : (grp == 1) ? (p.sb_out_w + l * 256 + 16 * (lane - 32)) : (p.nsa_out_w + l * 256 + 16 * (lane - 48));
    float wv[16];
#pragma unroll
    for (int i = 0; i < 16; ++i) wv[i] = w[i];
    for (int m = gw; m < T; m += NGW) {
        float v[16];
        const uint4* src = (const uint4*)(MIX + (size_t)m * 1024 + 16 * lane);
        unpack8(src[0], v); unpack8(src[1], v + 8);
        float ss = 0.f;
#pragma unroll
        for (int i = 0; i < 16; ++i) ss += v[i] * v[i];
        const float rsum = rowsum16(ss), gsum = (lane < 32) ? xsum16(rsum) : rsum;
        const float rstd = (grp == 0) ? rsqrtf(gsum * (1.f / 512.f) + EPS) : rsqrtf(gsum * (1.f / 256.f) + EPS);
        uint4 o[2]; unsigned* op = (unsigned*)o;
#pragma unroll
        for (int i = 0; i < 8; ++i) op[i] = pk2(v[2 * i] * rstd * wv[2 * i], v[2 * i + 1] * rstd * wv[2 * i + 1]);
        uint4* dst = (uint4*)(MIXN + (size_t)m * 1024 + 16 * lane);
        dst[0] = o[0]; dst[1] = o[1];
    }
}

__constant__ unsigned char CAND_I[50] = {0,0,0,0,0,0,0,0,0,0,0,0,0,0,0,0, 1,1,1,1,1,1,1,1, 2,2,2,2,2, 3,3,3,3, 4,4,4, 5,5, 6,6, 7,7, 8,9,10,11,12,13,14,15};
__constant__ unsigned char CAND_J[50] = {0,1,2,3,4,5,6,7,8,9,10,11,12,13,14,15, 0,1,2,3,4,5,6,7, 0,1,2,3,4, 0,1,2,3, 0,1,2, 0,1, 0,1, 0,1, 0,0,0,0,0,0,0,0};

__device__ __forceinline__ unsigned f2key(float v) { const unsigned u = __float_as_uint(v); return (u & 0x80000000u) ? ~u : (u | 0x80000000u); }
__device__ __forceinline__ float key2f(unsigned k) { const unsigned u = (k & 0x80000000u) ? (k ^ 0x80000000u) : ~k; return __uint_as_float(u); }
#define CE_DESC(a, b) do { const unsigned _hi = max((a), (b)), _lo = min((a), (b)); (a) = _hi; (b) = _lo; } while (0)
__device__ __forceinline__ void sort16_desc(unsigned (&v)[16]) {
#pragma unroll
    for (int k = 2; k <= 16; k <<= 1)
#pragma unroll
        for (int j = k >> 1; j > 0; j >>= 1)
#pragma unroll
            for (int i = 0; i < 16; ++i) { const int l = i ^ j; if (l > i) { if ((i & k) == 0) CE_DESC(v[i], v[l]); else CE_DESC(v[l], v[i]); } }
}
__device__ __forceinline__ void bitonic_merge16_desc(unsigned (&v)[16]) {
#pragma unroll
    for (int j = 8; j > 0; j >>= 1)
#pragma unroll
        for (int i = 0; i < 16; ++i) { const int l = i ^ j; if (l > i) CE_DESC(v[i], v[l]); }
}
__device__ __forceinline__ void merge_top16(unsigned (&a)[16], const unsigned (&b)[16]) {
#pragma unroll
    for (int i = 0; i < 16; ++i) a[i] = max(a[i], b[15 - i]);
    bitonic_merge16_desc(a);
}
template <int CTRL> __device__ __forceinline__ unsigned dpp_u(unsigned v) { return (unsigned)__builtin_amdgcn_update_dpp(0, (int)v, CTRL, 0xf, 0xf, true); }
template <int CTRL> __device__ __forceinline__ void merge_top16_lane(unsigned (&a)[16]) {
    unsigned t[16];
#pragma unroll
    for (int i = 0; i < 16; ++i) t[i] = max(a[i], dpp_u<CTRL>(a[15 - i]));
#pragma unroll
    for (int i = 0; i < 16; ++i) a[i] = t[i];
    bitonic_merge16_desc(a);
}

typedef __bf16 bf16x2_t __attribute__((ext_vector_type(2)));
__device__ __forceinline__ float dot2bf(unsigned a, unsigned b, float c) { return __builtin_amdgcn_fdot2_f32_bf16(__builtin_bit_cast(bf16x2_t, a), __builtin_bit_cast(bf16x2_t, b), c, false); }
__device__ __forceinline__ float gelu_erf(float v) {
    const float av = fabsf(v), t = __builtin_amdgcn_rcpf(av * 0.2316418882f + 1.0f);
    float q = t * 0.5307027145f + (-0.7265760135f); q = q * t + 0.7107068705f; q = q * t + (-0.142248368f); q = q * t + 0.127414796f; q = q * t;
    const float m = v * (q * __builtin_amdgcn_exp2f(v * v * (-0.72134752044f)));
    return v < 0.f ? m : v - m;
}
typedef float f32x2v __attribute__((ext_vector_type(2)));
__device__ __forceinline__ void ph_peer_fused(const Params& p, int l, const float* X1, float* XO, unsigned char* smem, int tid, int lane, int wave, const int tile) {
    float* SC = (float*)smem;
    unsigned* SK = (unsigned*)(SC + 128 * 130);
    int* EIL = (int*)smem;
    float* EGL = (float*)(EIL + 64 * 129);
    int* EIS = (int*)SK;
    float* EGS = (float*)(EIS + 64 * 128);
    const bf16* Q = (const bf16*)(p.ws + O_Q); const float* PS = (const float*)(p.ws + O_PS); float* RS = (float*)(smem + 132096);
    unsigned* TKC = (unsigned*)(smem + 132096 + 256);
    const bf16* KYB = (const bf16*)(p.ws + O_KYB) + (size_t)l * 2 * 128 * 128;
    const unsigned char* U8 = p.ws + O_UT + (size_t)l * 16384 * 1024; const unsigned char* V8 = U8 + 512;
    const float* USC = (const float*)(p.ws + O_USC) + (size_t)l * 16384; const float* VSC = (const float*)(p.ws + O_VSC) + (size_t)l * 16384;
    const int fr = lane & 15, fq = lane >> 4, pp = wave >> 2, tw = 16 * (wave & 3), gi = lane >> 4, li = lane & 15;
    {
        const int t0 = tile * 64;
        __syncthreads();
        s16x8 kf[8][4];
#pragma unroll
        for (int nt = 0; nt < 8; ++nt)
#pragma unroll
            for (int ks = 0; ks < 4; ++ks) kf[nt][ks] = *(const s16x8*)(KYB + (size_t)(pp * 128 + 16 * nt + fr) * 128 + 32 * ks + 8 * fq);
        s16x8 qn0, qn1, qn2, qn3;
        { const bf16* qp = Q + (size_t)(t0 + tw + fr) * 2048 + pp * 128 + 8 * fq; qn0 = *(const s16x8*)qp; qn1 = *(const s16x8*)(qp + 32); qn2 = *(const s16x8*)(qp + 64); qn3 = *(const s16x8*)(qp + 96); }
#pragma unroll 1
        for (int h = 0; h < 8; ++h) {
            {
                const s16x8 qf[4] = {qn0, qn1, qn2, qn3};
                if (h < 7) { const bf16* qp = Q + (size_t)(t0 + tw + fr) * 2048 + (h + 1) * 256 + pp * 128 + 8 * fq; qn0 = *(const s16x8*)qp; qn1 = *(const s16x8*)(qp + 32); qn2 = *(const s16x8*)(qp + 64); qn3 = *(const s16x8*)(qp + 96); }
#pragma unroll
                for (int nt = 0; nt < 8; ++nt) { f32x4v s = {0.f, 0.f, 0.f, 0.f};
#pragma unroll
                    for (int ks = 0; ks < 4; ++ks) s = MFMA16(qf[ks], kf[nt][ks], s);
#pragma unroll
                    for (int r = 0; r < 4; ++r) SC[((tw + 4 * fq + r) * 2 + pp) * 130 + 16 * nt + fr] = s[r]; }
            }
            __syncthreads();
            {
                const int row = tid >> 2, qd = tid & 3;
                unsigned a[16], b[16];
#pragma unroll
                for (int i = 0; i < 16; ++i) { a[i] = (f2key(SC[row * 130 + 4 * i + qd]) & ~127u) | (unsigned)(127 - (4 * i + qd));
                                               b[i] = (f2key(SC[row * 130 + 64 + 4 * i + qd]) & ~127u) | (unsigned)(127 - (64 + 4 * i + qd)); }
                sort16_desc(a); sort16_desc(b); merge_top16(a, b);
                merge_top16_lane<0xB1>(a); merge_top16_lane<0x4E>(a);
#pragma unroll
                for (int i = 0; i < 16; ++i) if ((i >> 2) == qd) SK[(h * 128 + row) * 16 + (i ^ (((row >> 1) & 3) << 2))] = a[i];
            }
            __syncthreads();
        }
        {
            const int h = tid >> 6, tk = tid & 63;
                const unsigned* ka = SK + (h * 128 + 2 * tk) * 16; const unsigned* kb = ka + 16; const int sx = (tk & 3) << 2;
                float av[16], bv[16];
#pragma unroll
                for (int i = 0; i < 16; ++i) { av[i] = key2f(ka[i ^ sx] & ~127u); bv[i] = key2f(kb[i ^ sx] & ~127u); }
                unsigned c0[16], c1[16], c2[16], c3[16];
#define CKEY(C, I, J) ((f2key(av[I] + bv[J]) & ~63u) | (unsigned)(63 - (C)))
#pragma unroll
                for (int j = 0; j < 16; ++j) c0[j] = CKEY(j, 0, j);
#pragma unroll
                for (int j = 0; j < 8; ++j) c1[j] = CKEY(16 + j, 1, j);
#pragma unroll
                for (int j = 0; j < 5; ++j) c1[8 + j] = CKEY(24 + j, 2, j);
#pragma unroll
                for (int j = 0; j < 3; ++j) c1[13 + j] = CKEY(29 + j, 3, j);
                c2[0] = CKEY(32, 3, 3);
#pragma unroll
                for (int j = 0; j < 3; ++j) c2[1 + j] = CKEY(33 + j, 4, j);
#pragma unroll
                for (int j = 0; j < 2; ++j) { c2[4 + j] = CKEY(36 + j, 5, j); c2[6 + j] = CKEY(38 + j, 6, j); c2[8 + j] = CKEY(40 + j, 7, j); }
#pragma unroll
                for (int i = 0; i < 6; ++i) c2[10 + i] = CKEY(42 + i, 8 + i, 0);
                c3[0] = CKEY(48, 14, 0); c3[1] = CKEY(49, 15, 0);
#pragma unroll
                for (int i = 2; i < 16; ++i) c3[i] = 0u;
#undef CKEY
                sort16_desc(c0); sort16_desc(c1); sort16_desc(c2); sort16_desc(c3);
                merge_top16(c0, c1); merge_top16(c2, c3); merge_top16(c0, c2);
                const float mx = key2f(c0[0] & ~63u);
                float rstd;
                {   const float4* ps = (const float4*)(PS + (size_t)(t0 + tk) * 16); const float4 s0 = ps[0], s1 = ps[1], s2 = ps[2], s3 = ps[3];
                    const float sq = ((s0.x + s0.y) + (s0.z + s0.w)) + ((s1.x + s1.y) + (s1.z + s1.w)) + ((s2.x + s2.y) + (s2.z + s2.w)) + ((s3.x + s3.y) + (s3.z + s3.w));
                    rstd = rsqrtf(sq * (1.f / D) + EPS); if (h == 0) RS[tk] = rstd; }
                float e[16], sum = 0.f; int ei[16];
#pragma unroll
                for (int r = 0; r < 16; ++r) { const int c = 63 - (int)(c0[r] & 63u);
                    e[r] = fexp((key2f(c0[r] & ~63u) - mx) * rstd); sum += e[r];
                    const int ia = 127 - (int)(ka[CAND_I[c] ^ sx] & 127u), ib = 127 - (int)(kb[CAND_J[c] ^ sx] & 127u);
                    ei[r] = ia * 128 + ib; }
                const float inv = 1.f / sum;
#pragma unroll
                for (int r = 0; r < 16; ++r) { EIL[tk * 129 + h * 16 + r] = ei[r];
                    EGL[tk * 129 + h * 16 + r] = __uint_as_float((pk2(0.f, e[r] * inv * VSC[ei[r]]) & 0xffff0000u) | (unsigned)f2bf(USC[ei[r]])); }
            }
        __syncthreads();
        {
            const int tk = tid >> 3, h = tid & 7;
            if (tid == 0) *TKC = 8u;
            if (tid >= 256 && l + 1 < NL) ((float4*)(smem + 132096 + 512 + 4096))[tid - 256] = ((const float4*)(p.norm1_w + (size_t)(l + 1) * D))[tid - 256];
            if (tid < 256) ((float4*)(smem + 132096 + 512))[tid] = ((const float4*)(p.norm2_w + (size_t)l * D))[tid];
            int ei[16]; float eg[16];
#pragma unroll
            for (int r = 0; r < 16; ++r) { ei[r] = EIL[tk * 129 + h * 16 + r]; eg[r] = EGL[tk * 129 + h * 16 + r]; }
            unsigned long long cw0 = 0ull, cw1 = 0ull;
#pragma unroll
            for (int r = 0; r < 16; ++r) { const int g = ei[r] >> 10; const unsigned long long one = 1ull << (8 * (g & 7)); if (g < 8) cw0 += one; else cw1 += one; }
            unsigned long long inc0 = cw0, inc1 = cw1;
#pragma unroll
            for (int o = 1; o < 8; o <<= 1) { const unsigned long long t0_ = __shfl_up(inc0, o, 8), t1_ = __shfl_up(inc1, o, 8); if (h >= o) { inc0 += t0_; inc1 += t1_; } }
            const unsigned long long tot0 = __shfl(inc0, 7, 8), tot1 = __shfl(inc1, 7, 8);
            unsigned long long pw0 = inc0 - cw0, pw1 = inc1 - cw1, run = 0ull;
#pragma unroll
            for (int g = 0; g < 8; ++g) { pw0 += run << (8 * g); run += (tot0 >> (8 * g)) & 255ull; }
#pragma unroll
            for (int g = 0; g < 8; ++g) { pw1 += run << (8 * g); run += (tot1 >> (8 * g)) & 255ull; }
#pragma unroll
            for (int r = 0; r < 16; ++r) { const int g = ei[r] >> 10, g8 = 8 * (g & 7); unsigned pos;
                if (g < 8) { pos = (unsigned)(pw0 >> g8) & 255u; pw0 += 1ull << g8; } else { pos = (unsigned)(pw1 >> g8) & 255u; pw1 += 1ull << g8; }
                EIS[tk * 128 + pos] = ei[r]; EGS[tk * 128 + pos] = eg[r]; }
        }
        __syncthreads();
        const bf16* X1b = (const bf16*)(p.ws + O_H2);
        uint4 pa0, pa1;
        { const uint4* xr = (const uint4*)(X1b + (size_t)(t0 + wave) * D); pa0 = nt_load16(xr + lane); pa1 = nt_load16(xr + lane + 64); }
#pragma unroll 1
        for (int tl = wave; tl < 64; ) {
            const int t = t0 + tl;
            unsigned nxv = 0u; if (lane == 0) nxv = __hip_atomic_fetch_add(TKC, 1u, __ATOMIC_RELAXED, __HIP_MEMORY_SCOPE_WORKGROUP);
            float acc[64];
            uint4* xbl = (uint4*)(smem + wave * 2048);
            {   const float4* wr = (const float4*)(smem + 132096 + 512); const float rs = RS[tl]; uint2* xw = (uint2*)xbl;
                float f0[8], f1[8]; unpack8(pa0, f0); unpack8(pa1, f1);
                { uint4* xraw = (uint4*)(smem + 16384 + wave * 2048); xraw[lane] = pa0; xraw[lane + 64] = pa1; }
                const float4 w0 = wr[2 * lane], w1 = wr[2 * lane + 1], w2 = wr[128 + 2 * lane], w3 = wr[128 + 2 * lane + 1];
                (void)xw;
                xbl[lane]      = make_uint4(pk2(f0[0] * rs * w0.x, f0[1] * rs * w0.y), pk2(f0[2] * rs * w0.z, f0[3] * rs * w0.w), pk2(f0[4] * rs * w1.x, f0[5] * rs * w1.y), pk2(f0[6] * rs * w1.z, f0[7] * rs * w1.w));
                xbl[64 + lane] = make_uint4(pk2(f1[0] * rs * w2.x, f1[1] * rs * w2.y), pk2(f1[2] * rs * w2.z, f1[3] * rs * w2.w), pk2(f1[4] * rs * w3.x, f1[5] * rs * w3.y), pk2(f1[6] * rs * w3.z, f1[7] * rs * w3.w)); }
            const int tln = __builtin_amdgcn_readfirstlane((int)nxv);
            if (tln < 64) { const uint4* xr = (const uint4*)(X1b + (size_t)(t0 + tln) * D); pa0 = nt_load16(xr + lane); pa1 = nt_load16(xr + lane + 64); }
            LDS_FENCE();
            const uint2* xb2 = (const uint2*)xbl;
#pragma unroll
            for (int i = 0; i < 64; ++i) acc[i] = 0.f;
#define GF_LOAD(S, IT) do { const int ei_ = EIS[tl * 128 + 4 * (IT) + gi]; S##g = EGS[tl * 128 + 4 * (IT) + gi]; \
                const unsigned char* ur_ = U8 + (size_t)ei_ * 1024 + li * 16; const unsigned char* vr_ = V8 + (size_t)ei_ * 1024 + li * 16; \
                S##u0 = *(const uint4*)ur_; S##u1 = *(const uint4*)(ur_ + 256); \
                S##v0 = *(const uint4*)vr_; S##v1 = *(const uint4*)(vr_ + 256); } while (0)
#define GF_COMP(S) do { float d0 = 0.f, d1 = 0.f; \
                {     \
                    const unsigned uw_[4] = {S##u0.x, S##u0.y, S##u0.z, S##u0.w}; \
                    _Pragma("unroll") for (int w = 0; w < 4; ++w) { const uint2 xa = xb2[2 * (16 * (2 * w) + li)], xc = xb2[2 * (16 * (2 * w + 1) + li)]; \
                        d0 = dot2bf(upb_fp4<0>(uw_[w]), xa.x, d0); d0 = dot2bf(upb_fp4<1>(uw_[w]), xa.y, d0); d0 = dot2bf(upb_fp4<2>(uw_[w]), xc.x, d0); d0 = dot2bf(upb_fp4<3>(uw_[w]), xc.y, d0); } } \
                {   const unsigned uw_[4] = {S##u1.x, S##u1.y, S##u1.z, S##u1.w}; \
                    _Pragma("unroll") for (int w = 0; w < 4; ++w) { const uint2 xa = xb2[2 * (16 * (2 * w) + li) + 1], xc = xb2[2 * (16 * (2 * w + 1) + li) + 1]; \
                        d1 = dot2bf(upb_fp4<0>(uw_[w]), xa.x, d1); d1 = dot2bf(upb_fp4<1>(uw_[w]), xa.y, d1); d1 = dot2bf(upb_fp4<2>(uw_[w]), xc.x, d1); d1 = dot2bf(upb_fp4<3>(uw_[w]), xc.y, d1); } } \
                const unsigned gb_ = __float_as_uint(S##g); const float d = rowsum16(d0 + d1) * __uint_as_float(gb_ << 16); const float coef = __uint_as_float(gb_ & 0xffff0000u) * gelu_erf(d); \
                __builtin_amdgcn_sched_barrier(0); \
                {   const unsigned vw_[4] = {S##v0.x, S##v0.y, S##v0.z, S##v0.w}; \
                    _Pragma("unroll") for (int w = 0; w < 4; ++w) { f32pair_t f; f = up_fp4<0>(vw_[w]); acc[8 * w] += coef * f[0]; acc[8 * w + 1] += coef * f[1]; f = up_fp4<1>(vw_[w]); acc[8 * w + 2] += coef * f[0]; acc[8 * w + 3] += coef * f[1]; \
                        f = up_fp4<2>(vw_[w]); acc[8 * w + 4] += coef * f[0]; acc[8 * w + 5] += coef * f[1]; f = up_fp4<3>(vw_[w]); acc[8 * w + 6] += coef * f[0]; acc[8 * w + 7] += coef * f[1]; } } \
                __builtin_amdgcn_sched_barrier(0); \
                {   const unsigned vw_[4] = {S##v1.x, S##v1.y, S##v1.z, S##v1.w}; \
                    _Pragma("unroll") for (int w = 0; w < 4; ++w) { f32pair_t f; f = up_fp4<0>(vw_[w]); acc[32 + 8 * w] += coef * f[0]; acc[32 + 8 * w + 1] += coef * f[1]; f = up_fp4<1>(vw_[w]); acc[32 + 8 * w + 2] += coef * f[0]; acc[32 + 8 * w + 3] += coef * f[1]; \
                        f = up_fp4<2>(vw_[w]); acc[32 + 8 * w + 4] += coef * f[0]; acc[32 + 8 * w + 5] += coef * f[1]; f = up_fp4<3>(vw_[w]); acc[32 + 8 * w + 6] += coef * f[0]; acc[32 + 8 * w + 7] += coef * f[1]; } } } while (0)
            uint4 Au0, Au1, Av0, Av1, Bu0, Bu1, Bv0, Bv1; float Ag, Bg;
            GF_LOAD(A, 0);
#pragma unroll 1
            for (int it = 0; it < 32; it += 2) {
                GF_LOAD(B, it + 1);
                GF_COMP(A);
                if (it + 2 < 32) GF_LOAD(A, it + 2);
                GF_COMP(B);
            }
#undef GF_LOAD
#undef GF_COMP
            float bsum[32];
#pragma unroll
            for (int m = 0; m < 32; ++m) { const int k = (m < 16) ? m : 16 + m;
                const auto r = __builtin_amdgcn_permlane32_swap(__float_as_uint(acc[k]), __float_as_uint(acc[k + 16]), false, false);
                bsum[m] = __uint_as_float(r[0]) + __uint_as_float(r[1]); }
            float o[16]; float ss = 0.f;
            {   float csum[16];
#pragma unroll
                for (int n = 0; n < 16; ++n) { const int m = (n < 8) ? n : 8 + n;
                    const auto r = __builtin_amdgcn_permlane16_swap(__float_as_uint(bsum[m]), __float_as_uint(bsum[m + 8]), false, false);
                    csum[n] = __uint_as_float(r[0]) + __uint_as_float(r[1]); }
#pragma unroll
                for (int jj = 0; jj < 2; ++jj)
#pragma unroll
                    for (int i = 0; i < 4; ++i) { o[8 * jj + i] = csum[4 * jj + i]; o[8 * jj + 4 + i] = csum[8 + 4 * jj + i]; } }
            float4 xres[4];
#pragma unroll
            for (int q = 0; q < 4; ++q) { const uint2 xq = *(const uint2*)((const bf16*)(smem + 16384 + wave * 2048) + 128 * (2 * gi + (q >> 1)) + 8 * li + 4 * (q & 1));
                xres[q] = make_float4(__uint_as_float(xq.x << 16), __uint_as_float(xq.x & 0xffff0000u), __uint_as_float(xq.y << 16), __uint_as_float(xq.y & 0xffff0000u)); }
#pragma unroll
            for (int q = 0; q < 4; ++q) { const size_t off = (size_t)t * D + 128 * (2 * gi + (q >> 1)) + 8 * li + 4 * (q & 1); const float4 x4 = xres[q];
                float4 r4 = {x4.x + o[4 * q], x4.y + o[4 * q + 1], x4.z + o[4 * q + 2], x4.w + o[4 * q + 3]};
                if (l + 1 < NL) nt_store(make_uint2(pk2(r4.x, r4.y), pk2(r4.z, r4.w)), (bf16*)(p.ws + O_X1) + off);
                else nt_store(r4, XO + off);
                o[4 * q] = r4.x; o[4 * q + 1] = r4.y; o[4 * q + 2] = r4.z; o[4 * q + 3] = r4.w;
                ss += r4.x * r4.x + r4.y * r4.y + r4.z * r4.z + r4.w * r4.w; }
            if (l + 1 < NL) {
                const float rstd = rsqrtf(xsum32(xsum16(rowsum16(ss))) * (1.f / D) + EPS);
#pragma unroll
                for (int jj = 0; jj < 2; ++jj) { const int col = 128 * (2 * gi + jj) + 8 * li;
                    const float4 w0 = *(const float4*)((const float*)(smem + 132096 + 512 + 4096) + col), w1 = *(const float4*)((const float*)(smem + 132096 + 512 + 4096) + col + 4);
                    uint4 ob; ob.x = pk2(o[8 * jj] * rstd * w0.x, o[8 * jj + 1] * rstd * w0.y); ob.y = pk2(o[8 * jj + 2] * rstd * w0.z, o[8 * jj + 3] * rstd * w0.w);
                    ob.z = pk2(o[8 * jj + 4] * rstd * w1.x, o[8 * jj + 5] * rstd * w1.y); ob.w = pk2(o[8 * jj + 6] * rstd * w1.z, o[8 * jj + 7] * rstd * w1.w);
                    nt_store(ob, (bf16*)(p.ws + O_H1) + (size_t)t * D + col); }
            }
            tl = tln;
        }
    }
}

#define LAS __attribute__((address_space(3)))
#define XB_TMO      128
#define XB_XCNT(j)  (256  + 64 * (j))
#define XB_XSUB(j)  (1280 + 64 * (j))
#define XB_XGEN(j)  (2304 + 64 * (j))
#define XB_TOP      3328
#define XB_TOPGEN   3392
#define XCD_BAR_WORDS 3456
#define XB_SPIN_CAP (1u << 18)

__device__ __forceinline__ unsigned xb_ld(unsigned* p)              { return __hip_atomic_load(p, __ATOMIC_RELAXED, __HIP_MEMORY_SCOPE_AGENT); }
__device__ __forceinline__ unsigned xb_add(unsigned* p, unsigned v) { return __hip_atomic_fetch_add(p, v, __ATOMIC_RELAXED, __HIP_MEMORY_SCOPE_AGENT); }
__device__ __forceinline__ unsigned xb_xcc_id() { return (unsigned)__builtin_amdgcn_s_getreg((3 << 11) | 20) & 0xFu; }
#define XB_SPIN(cond, bar) do { unsigned _sp = 0; while (cond) { __builtin_amdgcn_s_sleep(1); \
    if ((++_sp & 255u) == 0u) { if (xb_ld(&(bar)[XB_TMO])) break; if (_sp > XB_SPIN_CAP) { atomicAdd(&(bar)[XB_TMO], 1u); break; } } } } while (0)

struct XcdBarrier {
    unsigned* bar; unsigned x;
    volatile LAS unsigned* st;
};

__device__ __forceinline__ XcdBarrier xcd_barrier_post(unsigned* bar, volatile LAS unsigned* st) {
    XcdBarrier b; b.bar = bar; b.x = xb_xcc_id(); b.st = st;
    if (threadIdx.x == 0) (void)xb_add(&bar[XB_XCNT(b.x)], 1u);
    return b;
}
__device__ __forceinline__ void xcd_barrier_complete(unsigned* bar, unsigned x, unsigned& nloc, unsigned& nx) {
    const unsigned G = gridDim.x * gridDim.y * gridDim.z;
    unsigned sum, cnt, mine, sp = 0u;
    for (;;) {
        sum = 0u; cnt = 0u; mine = 0u;
#pragma unroll
        for (unsigned j = 0; j < 16; ++j) { const unsigned c = xb_ld(&bar[XB_XCNT(j)]); sum += c; cnt += (c > 0u) ? 1u : 0u; mine = (j == x) ? c : mine; }
        if (sum == G) break;
        __builtin_amdgcn_s_sleep(1);
        if ((++sp & 255u) == 0u) { if (xb_ld(&bar[XB_TMO])) break; if (sp > XB_SPIN_CAP) { atomicAdd(&bar[XB_TMO], 1u); break; } }
    }
    nloc = mine > 0u ? mine : 1u; nx = cnt > 0u ? cnt : 1u;
}

__device__ __forceinline__ void xcd_barrier(const XcdBarrier& b, const int tid_in) {
    asm volatile("s_waitcnt vmcnt(0)" ::: "memory");
    __syncthreads();
    if (tid_in == 0) {
        unsigned* bar = b.bar;
        __builtin_amdgcn_s_waitcnt(0);
        unsigned nloc = b.st[0], nx = b.st[1];
        if (nloc == 0u) { xcd_barrier_complete(bar, b.x, nloc, nx); b.st[0] = nloc; b.st[1] = nx; }
        const unsigned old = xb_add(&bar[XB_XSUB(b.x)], 1u);
        const unsigned gen = old / nloc;
        if (old + 1u == (gen + 1u) * nloc) {
            __builtin_amdgcn_fence(__ATOMIC_RELEASE, "agent");
            asm volatile("s_waitcnt vmcnt(0)" ::: "memory");
            const unsigned og = xb_add(&bar[XB_TOP], 1u);
            const unsigned tg = og / nx;
            if (og + 1u == (tg + 1u) * nx) xb_add(&bar[XB_TOPGEN], 1u);
            else XB_SPIN(xb_ld(&bar[XB_TOPGEN]) == tg, bar);
            __builtin_amdgcn_fence(__ATOMIC_ACQUIRE, "agent");
            xb_add(&bar[XB_XGEN(b.x)], 1u);
            asm volatile("s_waitcnt vmcnt(0)" ::: "memory");
        } else {
            XB_SPIN(xb_ld(&bar[XB_XGEN(b.x)]) == gen, bar);
            __builtin_amdgcn_fence(__ATOMIC_ACQUIRE, "agent");
            asm volatile("s_waitcnt vmcnt(0)" ::: "memory");
        }
    }
    __syncthreads();
}

__device__ __forceinline__ Params load_params() {
#if defined(__HIP_DEVICE_COMPILE__)
    const __attribute__((address_space(4))) Params* kp = (const __attribute__((address_space(4))) Params*)__builtin_amdgcn_kernarg_segment_ptr();
    asm volatile("" : "+s"(kp));
    return *kp;
#else
    return Params{};
#endif
}
#define PH(stmt) do { const Params p = load_params(); MKTID; stmt; } while (0)
__global__ void __launch_bounds__(NTHREADS) mega(Params p_unused) {
    extern __shared__ __attribute__((aligned(16))) unsigned char smem[];
    float* lds = (float*)smem;
    cg::grid_group grid = cg::this_grid();
    const int tid0 = threadIdx.x;
    const int wave0 = __builtin_amdgcn_readfirstlane(tid0 >> 6);
    volatile LAS unsigned* misc = (volatile LAS unsigned*)((LAS unsigned char*)smem + (LDS_BYTES - 64));
    if (tid0 < 16) misc[tid0] = 0u;
    if (blockIdx.x == 0) { const Params p = load_params(); unsigned* bw = (unsigned*)(p.ws + O_CTL) + 1024;
        for (int i = tid0; i < XCD_BAR_WORDS; i += NTHREADS) __hip_atomic_store(bw + i, 0u, __ATOMIC_RELAXED, __HIP_MEMORY_SCOPE_AGENT); }
    __syncthreads();
#define GSYNC() do { const Params pb = load_params(); MKTID; XcdBarrier bb; bb.bar = (unsigned*)(pb.ws + O_CTL) + 1024; bb.x = xb_xcc_id(); \
        bb.st = (volatile LAS unsigned*)((LAS unsigned char*)smem + (LDS_BYTES - 64)); xcd_barrier(bb, tid); } while (0)

#define MKTID int zero_v = 0; asm volatile("" : "+v"(zero_v)); \
        const int lane = (int)__builtin_amdgcn_mbcnt_hi(~0u, __builtin_amdgcn_mbcnt_lo(~0u, (unsigned)zero_v)), wave = wave0, tid = wave * 64 + lane; (void)lane; (void)tid
    REP(1) if (SEL(1)) PH(ph_prep(p, lds, tid, lane, wave));
    grid.sync();
    { const Params p = load_params(); (void)xcd_barrier_post((unsigned*)(p.ws + O_CTL) + 1024, misc); }
#pragma unroll 1
    for (int l = 0; l < NL; ++l) {
        REP(2) if (SEL(2)) {   const Params p = load_params(); MKTID;
            pg8::Gemm g{(const bf16*)(p.ws + O_H1), (const bf16*)(p.ws + O_WIN) + (size_t)l * INP * D, T, INP, D}; pg8::StaticOrder S; S.init(T, INP, gridDim.x, blockIdx.x);
            pg8::EpiBf16<0> E{(bf16*)(p.ws + O_PROJ), INP, nullptr, 0, 0, 1.f};
            pg8::gemm_phase<pg8::EpiBf16<0>, pg8::StaticOrder, true, true>((PG8_LAS unsigned char*)smem, g, S, E, tid); }
        GSYNC();
        REP(4) if (SEL(4)) { if (blockIdx.x >= 128) PH(ph_cmp_kv_fast(p, l, smem, tid, lane, wave, blockIdx.x - 128, gridDim.x - 128)); }
        REP(5) if (SEL(5)) PH(ph_ssd_p1(p, l, smem, tid, lane, wave, blockIdx.x, gridDim.x));
        REP(3) if (SEL(3)) { if (blockIdx.x < 128) PH(ph_elem(p, l, tid, blockIdx.x, 128, 0, 81920)); else PH(ph_elem(p, l, tid, blockIdx.x - 128, gridDim.x - 128, 81920, T * 6)); }
        GSYNC();
        REP(9) if (SEL(9)) PH(ph_ssd_scan(p, tid));
        GSYNC();
        REP(8) if (SEL(8)) PH(ph_ssd_p2(p, l, smem, tid, lane, wave, blockIdx.x, gridDim.x));
        REP(6) if (SEL(6)) PH(ph_sb_fast(p, smem, tid, lane, wave, blockIdx.x, gridDim.x));
        REP(7) if (SEL(7)) PH(ph_nsa_t(p, smem, tid, lane, wave, blockIdx.x, gridDim.x));
        GSYNC();
        REP(10) if (SEL(10)) PH(ph_mixnorm(p, l, lane, wave));
        GSYNC();
        REP(11) if (SEL(11)) {   const Params p = load_params(); MKTID; const float* xin = (l == 0) ? p.x : p.out; float* X1 = (float*)(p.ws + O_X1);
            pg8::Gemm g{(const bf16*)(p.ws + O_MIXN), (const bf16*)(p.ws + O_WOUT) + (size_t)l * D * D, T, D, D}; pg8::StaticOrder S; S.init(T, D, gridDim.x, blockIdx.x);
            pg8::EpiResF32 E{X1, xin, D, (bf16*)(p.ws + O_H2), (float*)(p.ws + O_PS), (l == 0) ? (const bf16*)nullptr : (const bf16*)(p.ws + O_X1)};
            pg8::gemm_phase<pg8::EpiResF32, pg8::StaticOrder, true, true>((PG8_LAS unsigned char*)smem, g, S, E, tid); }
        GSYNC();
        REP(12) if (SEL(12)) {   const Params p = load_params(); MKTID;
            pg8::Gemm g{(const bf16*)(p.ws + O_H2), (const bf16*)(p.ws + O_WQ) + (size_t)l * 2048 * D, T, 2048, D}; pg8::StaticOrder S; S.init(T, 2048, gridDim.x, blockIdx.x);
            pg8::EpiBf16<0> E{(bf16*)(p.ws + O_Q), 2048, nullptr, 0, 0, 1.f};
            pg8::gemm_phase<pg8::EpiBf16<0>, pg8::StaticOrder, true, true>((PG8_LAS unsigned char*)smem, g, S, E, tid); }
        GSYNC();
        REP(15) if (SEL(15)) {
#pragma unroll 1
            for (int tile = blockIdx.x; tile < T / 64; tile += gridDim.x) PH(ph_peer_fused(p, l, (const float*)(p.ws + O_X1), p.out, smem, tid, lane, wave, tile)); }
        if (l + 1 < NL) GSYNC();
    }
}

extern "C" void kernel_launch(void* const* d_in, const int* in_sizes, int n_in, void* d_out, int out_size, void* d_ws, size_t ws_size, hipStream_t stream) {
    static int grid = 0;
    if (grid == 0) {
        if (n_in != 21 || out_size != T * D || ws_size < WS_END) { fprintf(stderr, "kernel_launch: unexpected shapes (n_in %d out %d ws %zu)\n", n_in, out_size, ws_size); grid = -1; return; }
        int dev = 0, cus = 0, per_cu = 0;
        hipGetDevice(&dev);
        hipDeviceGetAttribute(&cus, hipDeviceAttributeMultiprocessorCount, dev);
        hipFuncSetAttribute((const void*)mega, hipFuncAttributeMaxDynamicSharedMemorySize, LDS_BYTES);
        hipOccupancyMaxActiveBlocksPerMultiprocessor(&per_cu, (const void*)mega, NTHREADS, LDS_BYTES);
        if (per_cu < 1) { fprintf(stderr, "kernel_launch: occupancy query says %d blocks/CU\n", per_cu); per_cu = 1; }
        grid = cus;
        (void)hipGetLastError();
    }
    if (grid < 0) return;
    Params p{};
    const float** pp = (const float**)&p;
    for (int i = 0; i < 21; ++i) pp[i] = (const float*)d_in[i];
    p.out = (float*)d_out; p.ws = (unsigned char*)d_ws;
    void* args[] = {&p};
    hipError_t e = hipLaunchCooperativeKernel((const void*)mega, dim3(grid), dim3(NTHREADS), args, LDS_BYTES, stream);
    if (e != hipSuccess) fprintf(stderr, "cooperative launch failed: %s (grid %d)\n", hipGetErrorString(e), grid);
}
```
